# Optimizing an MI355X kernel written in HIP

```python
import math
import jax, jax.numpy as jnp
from jax import lax
import numpy as np

D_MODEL = 1024
BATCH = 8
SEQ = 2048
DEPTH = 4

N_MIXERS = 3
EPS = 1e-6
SB_HEAD_DIM = 64
SB_HEADS = D_MODEL // SB_HEAD_DIM
Q_BLOCK = 128
CHUNK = 128
SG_WIDTH = D_MODEL
SG_GROUPS = 8
SG_HEAD_DIM = SG_WIDTH // SG_GROUPS
SSM_GROUP = 16
SSM_GROUPS = D_MODEL // SSM_GROUP
SSM_STATE = 64
DT_MIN = 1e-3
DT_MAX = 1e-1
D_FF = 2816
CONV_K = 3
N_A = (DEPTH + 2) // 3
N_B = (DEPTH + 1) // 3
N_C = DEPTH // 3

kernel_name = "hybrid_stickbreak_gmlp_s5_trunk"


def rmsnorm(x, g):
    xf = x.astype(jnp.float32)
    y = xf * lax.rsqrt(jnp.mean(xf * xf, axis=-1, keepdims=True) + EPS) * g.astype(jnp.float32)
    return y.astype(x.dtype)


def stick_breaking_attention(xn, w_qkv, w_o):
    B, L, _ = xn.shape
    qkv = (xn @ w_qkv).reshape(B, L, 3, SB_HEADS, SB_HEAD_DIM).astype(jnp.float32)
    q = qkv[:, :, 0] * (SB_HEAD_DIM ** -0.5)
    k = qkv[:, :, 1]
    v = qkv[:, :, 2]
    blocks = []
    for i in range(L // Q_BLOCK):
        t0 = i * Q_BLOCK
        t1 = t0 + Q_BLOCK
        qb, kb, vb = q[:, t0:t1], k[:, :t1], v[:, :t1]
        z = jnp.einsum('bthd,bshd->bhts', qb, kb)
        t_pos = t0 + jnp.arange(Q_BLOCK)
        s_pos = jnp.arange(t1)
        mask = s_pos[None, :] < t_pos[:, None]
        log_1m = jnp.where(mask, jax.nn.log_sigmoid(-z), 0.0)
        log_w = jax.nn.log_sigmoid(z) + lax.cumsum(log_1m, axis=3, reverse=True) - log_1m
        w = jnp.where(mask, jnp.exp(log_w), 0.0)
        blocks.append(jnp.einsum('bhts,bshd->bthd', w, vb))
    o = jnp.concatenate(blocks, axis=1).reshape(B, L, D_MODEL).astype(xn.dtype)
    return o @ w_o


def chunked_spatial_gating(xn, w_in, v_norm_g, w_s, b_s, w_o):
    B, L, _ = xn.shape
    h = jax.nn.gelu(xn @ w_in)
    u, v = jnp.split(h, 2, axis=-1)
    v = rmsnorm(v, v_norm_g)
    v = v.reshape(B, L // CHUNK, CHUNK, SG_GROUPS, SG_HEAD_DIM)
    w_causal = jnp.tril(w_s)
    sv = jnp.einsum('gts,bcsgd->bctgd', w_causal, v) + b_s.T[:, :, None]
    return (u * sv.reshape(B, L, SG_WIDTH)) @ w_o


def _complex_affine_combine(e1, e2):
    a1r, a1i, b1r, b1i = e1
    a2r, a2i, b2r, b2i = e2
    ar = a2r * a1r - a2i * a1i
    ai = a2r * a1i + a2i * a1r
    br = a2r * b1r - a2i * b1i + b2r
    bi = a2r * b1i + a2i * b1r + b2i
    return (ar, ai, br, bi)


def s5_layer(xn, w_in, lam_re, lam_im, log_dt, b_re, b_im, c_re, c_im, d_skip, w_glu):
    B, L, _ = xn.shape
    u = (xn @ w_in).astype(jnp.float32)
    ug = u.reshape(B, L, SSM_GROUPS, SSM_GROUP)
    lr = jnp.minimum(lam_re.astype(jnp.float32), -1e-4)
    li = lam_im.astype(jnp.float32)
    dt = jnp.exp(log_dt.astype(jnp.float32))[:, None]
    mag = jnp.exp(dt * lr)
    ar = mag * jnp.cos(dt * li)
    ai = mag * jnp.sin(dt * li)
    den = lr * lr + li * li
    coef_re = ((ar - 1.0) * lr + ai * li) / den
    coef_im = (ai * lr - (ar - 1.0) * li) / den
    br32, bi32 = b_re.astype(jnp.float32), b_im.astype(jnp.float32)
    bbar_re = coef_re[..., None] * br32 - coef_im[..., None] * bi32
    bbar_im = coef_re[..., None] * bi32 + coef_im[..., None] * br32
    bu_re = jnp.einsum('gph,blgh->blgp', bbar_re, ug)
    bu_im = jnp.einsum('gph,blgh->blgp', bbar_im, ug)
    a_re = jnp.broadcast_to(ar, (1, L, SSM_GROUPS, SSM_STATE))
    a_im = jnp.broadcast_to(ai, (1, L, SSM_GROUPS, SSM_STATE))
    _, _, xr, xi = lax.associative_scan(_complex_affine_combine, (a_re, a_im, bu_re, bu_im), axis=1)
    y = (jnp.einsum('ghp,blgp->blgh', c_re.astype(jnp.float32), xr)
         - jnp.einsum('ghp,blgp->blgh', c_im.astype(jnp.float32), xi))
    y = y.reshape(B, L, D_MODEL) + d_skip.astype(jnp.float32) * u
    hg = jax.nn.gelu(y).astype(xn.dtype) @ w_glu
    a, g = jnp.split(hg, 2, axis=-1)
    return a * jax.nn.sigmoid(g)


def causal_depthwise_conv(h, w, b):
    L = h.shape[1]
    hp = jnp.pad(h, ((0, 0), (CONV_K - 1, 0), (0, 0)))
    y = hp[:, 0:L] * w[0]
    for kk in range(1, CONV_K):
        y = y + hp[:, kk:kk + L] * w[kk]
    return y + b


def conv_gated_ffn(xn, w_up, conv_w, conv_b, w_down):
    h = causal_depthwise_conv(xn @ w_up, conv_w, conv_b)
    a, g = jnp.split(h, 2, axis=-1)
    return (jax.nn.silu(g) * a) @ w_down


def setup_inputs(seed: int = 0) -> dict:
    key = jax.random.key(seed)
    ks = jax.random.split(key, 32)
    f32 = jnp.float32

    def nrm(k, shape, scale):
        return jax.random.normal(k, shape, f32) * scale

    x = nrm(ks[0], (BATCH, SEQ, D_MODEL), 1.0)
    norm_g = 1.0 + nrm(ks[1], (DEPTH, 2, D_MODEL), 0.05)
    final_norm_g = 1.0 + nrm(ks[2], (D_MODEL,), 0.05)
    sb_w_qkv = nrm(ks[3], (N_A, D_MODEL, 3 * D_MODEL), D_MODEL ** -0.5)
    sb_w_o = nrm(ks[4], (N_A, D_MODEL, D_MODEL), D_MODEL ** -0.5)
    sg_w_in = nrm(ks[5], (N_B, D_MODEL, 2 * SG_WIDTH), D_MODEL ** -0.5)
    sg_norm_g = 1.0 + nrm(ks[6], (N_B, SG_WIDTH), 0.05)
    sg_w_s = nrm(ks[7], (N_B, SG_GROUPS, CHUNK, CHUNK), CHUNK ** -0.5)
    sg_b = 1.0 + nrm(ks[8], (N_B, SG_GROUPS, CHUNK), 0.1)
    sg_w_o = nrm(ks[9], (N_B, SG_WIDTH, D_MODEL), SG_WIDTH ** -0.5)
    ssm_w_in = nrm(ks[10], (N_C, D_MODEL, D_MODEL), D_MODEL ** -0.5)
    ssm_lam_re = -0.5 + nrm(ks[11], (N_C, SSM_GROUPS, SSM_STATE), 0.01)
    ssm_lam_im = (jnp.pi * jnp.arange(SSM_STATE, dtype=f32)
                  + nrm(ks[12], (N_C, SSM_GROUPS, SSM_STATE), 0.01))
    ssm_log_dt = jax.random.uniform(ks[13], (N_C, SSM_GROUPS), f32,
                                    minval=math.log(DT_MIN), maxval=math.log(DT_MAX))
    ssm_b_re = nrm(ks[14], (N_C, SSM_GROUPS, SSM_STATE, SSM_GROUP), (2 * SSM_GROUP) ** -0.5)
    ssm_b_im = nrm(ks[15], (N_C, SSM_GROUPS, SSM_STATE, SSM_GROUP), (2 * SSM_GROUP) ** -0.5)
    ssm_c_re = nrm(ks[16], (N_C, SSM_GROUPS, SSM_GROUP, SSM_STATE), SSM_STATE ** -0.5)
    ssm_c_im = nrm(ks[17], (N_C, SSM_GROUPS, SSM_GROUP, SSM_STATE), SSM_STATE ** -0.5)
    ssm_d = nrm(ks[18], (N_C, D_MODEL), 1.0)
    ssm_w_glu = nrm(ks[19], (N_C, D_MODEL, 2 * D_MODEL), D_MODEL ** -0.5)
    ffn_w_up = nrm(ks[20], (DEPTH, D_MODEL, 2 * D_FF), D_MODEL ** -0.5)
    ffn_conv_w = nrm(ks[21], (DEPTH, CONV_K, 2 * D_FF), CONV_K ** -0.5)
    ffn_conv_b = nrm(ks[22], (DEPTH, 2 * D_FF), 0.01)
    ffn_w_down = nrm(ks[23], (DEPTH, D_FF, D_MODEL), D_FF ** -0.5)
    return {
        "x": x, "norm_g": norm_g, "final_norm_g": final_norm_g,
        "sb_w_qkv": sb_w_qkv, "sb_w_o": sb_w_o,
        "sg_w_in": sg_w_in, "sg_norm_g": sg_norm_g, "sg_w_s": sg_w_s, "sg_b": sg_b, "sg_w_o": sg_w_o,
        "ssm_w_in": ssm_w_in, "ssm_lam_re": ssm_lam_re, "ssm_lam_im": ssm_lam_im,
        "ssm_log_dt": ssm_log_dt, "ssm_b_re": ssm_b_re, "ssm_b_im": ssm_b_im,
        "ssm_c_re": ssm_c_re, "ssm_c_im": ssm_c_im, "ssm_d": ssm_d, "ssm_w_glu": ssm_w_glu,
        "ffn_w_up": ffn_w_up, "ffn_conv_w": ffn_conv_w, "ffn_conv_b": ffn_conv_b,
        "ffn_w_down": ffn_w_down,
    }


def reference(x, norm_g, final_norm_g, sb_w_qkv, sb_w_o, sg_w_in, sg_norm_g, sg_w_s, sg_b, sg_w_o,
              ssm_w_in, ssm_lam_re, ssm_lam_im, ssm_log_dt, ssm_b_re, ssm_b_im, ssm_c_re, ssm_c_im,
              ssm_d, ssm_w_glu, ffn_w_up, ffn_conv_w, ffn_conv_b, ffn_w_down):
    for i in range(DEPTH):
        mixer = i % N_MIXERS
        j = i // N_MIXERS
        xn = rmsnorm(x, norm_g[i, 0])
        if mixer == 0:
            m = stick_breaking_attention(xn, sb_w_qkv[j], sb_w_o[j])
        elif mixer == 1:
            m = chunked_spatial_gating(xn, sg_w_in[j], sg_norm_g[j], sg_w_s[j], sg_b[j], sg_w_o[j])
        else:
            m = s5_layer(xn, ssm_w_in[j], ssm_lam_re[j], ssm_lam_im[j], ssm_log_dt[j],
                         ssm_b_re[j], ssm_b_im[j], ssm_c_re[j], ssm_c_im[j], ssm_d[j], ssm_w_glu[j])
        x = x + m.astype(x.dtype)
        f = conv_gated_ffn(rmsnorm(x, norm_g[i, 1]), ffn_w_up[i], ffn_conv_w[i], ffn_conv_b[i],
                           ffn_w_down[i])
        x = x + f.astype(x.dtype)
    return rmsnorm(x, final_norm_g)
```

```cpp
#define DBG_ON {1,1,1,1,1, 1,1,1,1,1, 1,1,1,1,1, 1,1,1,1,1}
#include <hip/hip_runtime.h>
#include <hip/hip_cooperative_groups.h>
#include <cstdio>
#include <cstdint>
namespace cg = cooperative_groups;
namespace pg8 {
#define PG8_LAS __attribute__((address_space(3)))
typedef unsigned short bf16_t;
typedef short bf16x8 __attribute__((ext_vector_type(8)));
typedef float f32x4 __attribute__((ext_vector_type(4)));
typedef unsigned u32x4 __attribute__((ext_vector_type(4)));
constexpr int BM = 256, BK = 64, HALF = 128, HTB = HALF * BK * 2  , STAGE_BYTES = 8 * HTB, NXCD = 8, WGM = 8;

__host__ __device__ __forceinline__ int lds_byte(int r, int c) { const int st = (r >> 4) * 2 + (c >> 5), rr = r & 15, cc = c & 31, ob = rr * 64 + cc * 2; return st * 1024 + (ob ^ (((ob >> 9) & 1) << 5)); }
__host__ __device__ __forceinline__ void stage_rc(int b, int& R, int& C) { const int st = b / 1024, sb = b % 1024, swz = sb ^ (((sb >> 9) & 1) << 5); R = (st >> 1) * 16 + swz / 64; C = (st & 1) * 32 + (swz % 64) / 2; }
__host__ __device__ __forceinline__ int perm32(int rho) { const int n = rho >> 4, i = rho & 15; return 8 * (i >> 2) + 4 * n + (i & 3); }

struct Unit { int pm, pn; };
struct Gemm { const bf16_t* A; const bf16_t* Bt; int M, N, K; };

struct StaticOrder {
    int nM, nN, nwg, G, c;
    __host__ __device__ void init(int M, int N, int G_, int c_) { nM = M / BM; nN = N / BM; nwg = nM * nN; G = G_; c = c_; }
    __host__ __device__ bool next(int i, Unit& u) const {
        const long L = (long)i * G + c; if (L >= nwg) return false;
        int wgid = (int)L; { const int q = nwg / NXCD, r = nwg % NXCD, xcd = wgid % NXCD, off = wgid / NXCD; wgid = (xcd < r ? xcd * (q + 1) : r * (q + 1) + (xcd - r) * q) + off; }
        const int nig = WGM * nN, gid = wgid / nig, fm = gid * WGM, gsz = (nM - fm) < WGM ? (nM - fm) : WGM;
        u.pm = fm + ((wgid % nig) % gsz); u.pn = (wgid % nig) / gsz; return true;
    }
    __device__ __forceinline__ void a_ready(const Unit&) const {}
    __device__ __forceinline__ void done(const Unit&) const {}
};

__device__ __forceinline__ unsigned cvt_pk_bf16(float lo, float hi) { unsigned r; asm volatile("v_cvt_pk_bf16_f32 %0, %1, %2" : "=v"(r) : "v"(lo), "v"(hi)); return r; }
template <class Epi, class Sched, bool ALIGN_EPI = false, bool SP2 = false>
__device__ __forceinline__ void gemm_phase(PG8_LAS unsigned char* lds, const Gemm g, const Sched& S, const Epi& E) {
    int tid = threadIdx.x; asm volatile("" : "+v"(tid));
    const int wid = __builtin_amdgcn_readfirstlane(tid >> 6), lane = tid & 63, wr = wid >> 2, wc = wid & 3, fr = lane & 15, fq = lane >> 4;
    const int K = g.K, nt = K / BK;
    unsigned voffA[2], voffB[2];
#pragma unroll
    for (int i = 0; i < 2; ++i) { int R, C; stage_rc(tid * 16 + i * 8192, R, C); const int Rb = Epi::PERM ? ((R & ~31) + perm32(R & 31)) : R;
        voffA[i] = (unsigned)(R * K + C) * 2u; voffB[i] = (unsigned)(Rb * K + C) * 2u; }
    const size_t kstep = (size_t)(BK * 2);
    const size_t hstep = (size_t)HALF * K * 2;
    const size_t tstep = 2 * hstep;
    const unsigned ldsw = (unsigned)wid * 1024u;
    const int aoff = lds_byte(wr * 64 + fr, fq * 8), boff = lds_byte(wc * 32 + fr, fq * 8);
#define PG8_SA(b, h) (((b) * 2 + (h)) * HTB)
#define PG8_SB(b, h) ((4 + (b) * 2 + (h)) * HTB)
#define PG8_STAGE(bufoff, gbase, voff) do { _Pragma("unroll") for (int _i = 0; _i < 2; ++_i) \
        __builtin_amdgcn_global_load_lds((const unsigned*)((const char*)(gbase) + (voff)[_i]), (PG8_LAS unsigned*)(lds + (bufoff) + ldsw + _i * 8192), 16, 0, 0); } while (0)
#define PG8_LDA(dst, b, h) do { _Pragma("unroll") for (int m = 0; m < 4; ++m) _Pragma("unroll") for (int k = 0; k < 2; ++k) dst[m][k] = *(const PG8_LAS bf16x8*)(lds + PG8_SA(b, h) + aoff + m * 2048 + k * 1024); } while (0)
#define PG8_LDB(dst, b, h) do { _Pragma("unroll") for (int n = 0; n < 2; ++n) _Pragma("unroll") for (int k = 0; k < 2; ++k) dst[n][k] = *(const PG8_LAS bf16x8*)(lds + PG8_SB(b, h) + boff + n * 2048 + k * 1024); } while (0)
#define PG8_MMA(ai, bj, At, Bt) do { __builtin_amdgcn_s_setprio(1); _Pragma("unroll") for (int m = 0; m < 4; ++m) _Pragma("unroll") for (int n = 0; n < 2; ++n) _Pragma("unroll") for (int k = 0; k < 2; ++k) \
        acc[ai][bj][m][n] = __builtin_amdgcn_mfma_f32_16x16x32_bf16(Bt[n][k], At[m][k], acc[ai][bj][m][n], 0, 0, 0); __builtin_amdgcn_s_setprio(0); } while (0)
#define PG8_WAIT_V(n) asm volatile("s_waitcnt vmcnt(" #n ")" ::: "memory")
#define PG8_WAIT_L(n) asm volatile("s_waitcnt lgkmcnt(" #n ")" ::: "memory")
#define PG8_BAR __builtin_amdgcn_s_barrier()
#define PG8_SCHED __builtin_amdgcn_sched_barrier(0)
    Unit cur, nxt; int ui = 0;
    if (!S.next(0, cur)) return;
    f32x4 acc[2][2][4][2];
#pragma unroll
    for (int a = 0; a < 2; ++a)
#pragma unroll
        for (int b = 0; b < 2; ++b)
#pragma unroll
            for (int m = 0; m < 4; ++m)
#pragma unroll
                for (int n = 0; n < 2; ++n) acc[a][b][m][n] = (f32x4){0.f, 0.f, 0.f, 0.f};
    bf16x8 At[4][2], B0[2][2], B1[2][2];
    const char* cA = (const char*)g.A + (size_t)cur.pm * tstep; const char* cB = (const char*)g.Bt + (size_t)cur.pn * tstep;
    S.a_ready(cur);
    if constexpr (SP2) {
        PG8_STAGE(PG8_SB(0, 0), cB, voffB); PG8_STAGE(PG8_SB(0, 1), cB + hstep, voffB); PG8_STAGE(PG8_SA(0, 0), cA, voffA); PG8_STAGE(PG8_SA(0, 1), cA + hstep, voffA);
        if (wr == 1) PG8_BAR;
        PG8_WAIT_V(2); PG8_BAR;
        PG8_STAGE(PG8_SB(1, 0), cB + kstep, voffB); PG8_STAGE(PG8_SA(1, 0), cA + kstep, voffA); PG8_STAGE(PG8_SB(1, 1), cB + hstep + kstep, voffB);
        PG8_WAIT_V(6); PG8_BAR;
    } else {
        PG8_STAGE(PG8_SB(0, 0), cB, voffB); PG8_STAGE(PG8_SA(0, 0), cA, voffA); PG8_STAGE(PG8_SB(0, 1), cB + hstep, voffB); PG8_STAGE(PG8_SA(0, 1), cA + hstep, voffA);
        if (wr == 1) PG8_BAR;
        PG8_WAIT_V(4); PG8_BAR;
        PG8_STAGE(PG8_SB(1, 0), cB + kstep, voffB); PG8_STAGE(PG8_SA(1, 0), cA + kstep, voffA); PG8_STAGE(PG8_SB(1, 1), cB + hstep + kstep, voffB);
        PG8_WAIT_V(6); PG8_BAR;
    }
    for (;;) {
        const bool has_next = S.next(ui + 1, nxt);
        const char* nA = has_next ? (const char*)g.A + (size_t)nxt.pm * tstep : cA; const char* nB = has_next ? (const char*)g.Bt + (size_t)nxt.pn * tstep : cB;
        for (int t = 0; t < nt; t += 2) {
            const bool last = (t == nt - 2);
            const char* a1 = cA + (size_t)(t + 1) * kstep;
            const char* a2 = last ? nA : cA + (size_t)(t + 2) * kstep; const char* b2 = last ? nB : cB + (size_t)(t + 2) * kstep;
            const char* a3 = a2 + kstep; const char* b3 = b2 + kstep;
            if (last && has_next) S.a_ready(nxt);
            if constexpr (SP2) {
            PG8_LDB(B0, 0, 0); PG8_LDB(B1, 0, 1); PG8_SCHED; PG8_LDA(At, 0, 0); PG8_STAGE(PG8_SA(1, 1), a1 + hstep, voffA);
            PG8_WAIT_V(8); PG8_WAIT_L(0); PG8_BAR; PG8_MMA(0, 0, At, B0); PG8_MMA(0, 1, At, B1); PG8_BAR; PG8_SCHED;
            PG8_LDA(At, 0, 1); PG8_STAGE(PG8_SB(0, 0), b2, voffB); PG8_STAGE(PG8_SB(0, 1), b2 + hstep, voffB); PG8_STAGE(PG8_SA(0, 0), a2, voffA);
            PG8_WAIT_V(8); PG8_WAIT_L(0); PG8_BAR; PG8_MMA(1, 0, At, B0); PG8_MMA(1, 1, At, B1); PG8_BAR; PG8_SCHED;
            PG8_LDB(B0, 1, 0); PG8_LDB(B1, 1, 1); PG8_SCHED; PG8_LDA(At, 1, 0); PG8_STAGE(PG8_SA(0, 1), a2 + hstep, voffA);
            PG8_WAIT_V(8); PG8_WAIT_L(0); PG8_BAR; PG8_MMA(0, 0, At, B0); PG8_MMA(0, 1, At, B1); PG8_BAR; PG8_SCHED;
            PG8_LDA(At, 1, 1); PG8_STAGE(PG8_SB(1, 0), b3, voffB); PG8_STAGE(PG8_SB(1, 1), b3 + hstep, voffB); PG8_STAGE(PG8_SA(1, 0), a3, voffA);
            PG8_WAIT_V(8); PG8_WAIT_L(0); PG8_BAR; PG8_MMA(1, 0, At, B0); PG8_MMA(1, 1, At, B1); PG8_BAR; PG8_SCHED;
            } else {
            PG8_LDB(B0, 0, 0); PG8_SCHED; PG8_LDA(At, 0, 0); PG8_STAGE(PG8_SA(1, 1), a1 + hstep, voffA);
            PG8_WAIT_L(8); PG8_BAR; PG8_WAIT_L(0); PG8_MMA(0, 0, At, B0); PG8_BAR; PG8_SCHED;
            PG8_LDB(B1, 0, 1); PG8_STAGE(PG8_SB(0, 0), b2, voffB);
            PG8_BAR; PG8_WAIT_L(0); PG8_MMA(0, 1, At, B1); PG8_BAR;
            PG8_LDA(At, 0, 1); PG8_STAGE(PG8_SA(0, 0), a2, voffA);
            PG8_BAR; PG8_WAIT_L(0); PG8_MMA(1, 0, At, B0); PG8_BAR; PG8_SCHED;
            PG8_STAGE(PG8_SB(0, 1), b2 + hstep, voffB);
            PG8_WAIT_V(6); PG8_BAR; PG8_MMA(1, 1, At, B1); PG8_BAR;
            PG8_LDB(B0, 1, 0); PG8_SCHED; PG8_LDA(At, 1, 0); PG8_STAGE(PG8_SA(0, 1), a2 + hstep, voffA);
            PG8_WAIT_L(8); PG8_BAR; PG8_WAIT_L(0); PG8_MMA(0, 0, At, B0); PG8_BAR; PG8_SCHED;
            PG8_LDB(B1, 1, 1); PG8_STAGE(PG8_SB(1, 0), b3, voffB);
            PG8_BAR; PG8_WAIT_L(0); PG8_MMA(0, 1, At, B1); PG8_BAR;
            PG8_LDA(At, 1, 1); PG8_STAGE(PG8_SA(1, 0), a3, voffA);
            PG8_BAR; PG8_WAIT_L(0); PG8_MMA(1, 0, At, B0); PG8_BAR; PG8_SCHED;
            PG8_STAGE(PG8_SB(1, 1), b3 + hstep, voffB);
            PG8_WAIT_V(6); PG8_BAR; PG8_MMA(1, 1, At, B1); PG8_BAR;
            }
        }
        if constexpr (ALIGN_EPI) { if (wr == 0) PG8_BAR; }
        if constexpr (!Epi::AFTER_DRAIN) { E(acc, cur, wr, wc, fr, fq); S.done(cur); }
        if (!has_next) break;
#pragma unroll
        for (int a = 0; a < 2; ++a)
#pragma unroll
            for (int b = 0; b < 2; ++b)
#pragma unroll
                for (int m = 0; m < 4; ++m)
#pragma unroll
                    for (int n = 0; n < 2; ++n) acc[a][b][m][n] = (f32x4){0.f, 0.f, 0.f, 0.f};
        cur = nxt; cA = nA; cB = nB; ++ui;
        if constexpr (ALIGN_EPI) { if (wr == 1) PG8_BAR; }
    }
    PG8_WAIT_V(0);
    if constexpr (!ALIGN_EPI) { if (wr == 0) PG8_BAR; }
    PG8_BAR;
    if constexpr (Epi::AFTER_DRAIN) { E.fused(acc, cur, wr, wc, fr, fq, lds, wid, lane); S.done(cur); }
#undef PG8_SA
#undef PG8_SB
#undef PG8_STAGE
#undef PG8_LDA
#undef PG8_LDB
#undef PG8_MMA
#undef PG8_WAIT_V
#undef PG8_WAIT_L
#undef PG8_BAR
#undef PG8_SCHED
}
}

namespace pg8 {
typedef float f32x2 __attribute__((ext_vector_type(2)));
typedef __bf16 bf16x2_t __attribute__((ext_vector_type(2)));
typedef unsigned u32x2v __attribute__((ext_vector_type(2)));
constexpr int MROWS = 16384, DM = 1024, DFF = 2816, DFF2 = 5632;
constexpr float RMS_EPS = 1e-6f;
__device__ __forceinline__ unsigned pkbf(float lo, float hi) { f32x2 v = {lo, hi}; bf16x2_t b = __builtin_convertvector(v, bf16x2_t); return __builtin_bit_cast(unsigned, b); }
__device__ __forceinline__ u32x4 pk8(f32x4 a, f32x4 b) { u32x4 w; w.x = pkbf(a[0], a[1]); w.y = pkbf(a[2], a[3]); w.z = pkbf(b[0], b[1]); w.w = pkbf(b[2], b[3]); return w; }
typedef unsigned long long rss_t;
constexpr float RSS_SCALE = 1048576.0f;
__device__ __forceinline__ rss_t rss_of(float sq) { return (rss_t)(sq * RSS_SCALE + 0.5f); }
__device__ __forceinline__ void rss_add(rss_t* p, float sq) { (void)__hip_atomic_fetch_add(p, rss_of(sq), __ATOMIC_RELAXED, __HIP_MEMORY_SCOPE_AGENT); }
__device__ __forceinline__ float rstd_of(rss_t ss) { return rsqrtf((float)ss * (1.0f / (1024.0f * RSS_SCALE)) + RMS_EPS); }
__device__ __forceinline__ float sigmoidf_fast(float g) { return __builtin_amdgcn_rcpf(1.0f + __expf(-g)); }
__device__ __forceinline__ float gelu_tanh(float x) { const float u = x * (1.5957691216057308f + 0.07135481627159f * x * x); return x * sigmoidf_fast(u); }
__device__ __forceinline__ f32x4 gelu4(f32x4 v) { f32x4 o; o[0] = gelu_tanh(v[0]); o[1] = gelu_tanh(v[1]); o[2] = gelu_tanh(v[2]); o[3] = gelu_tanh(v[3]); return o; }
__device__ __forceinline__ float sumsq4(f32x4 v) { return (v[0] * v[0] + v[1] * v[1]) + (v[2] * v[2] + v[3] * v[3]); }
#define PG8_DPP_FN(name, ctl) __device__ __forceinline__ float name(float x) { float r; asm("s_nop 1\n\tv_mov_b32_dpp %0, %1 " ctl " row_mask:0xf bank_mask:0xf bound_ctrl:1" : "=v"(r) : "v"(x)); return r; }
PG8_DPP_FN(dpp_shr1, "row_shr:1") PG8_DPP_FN(dpp_shr2, "row_shr:2") PG8_DPP_FN(dpp_shl15, "row_shl:15") PG8_DPP_FN(dpp_shl14, "row_shl:14")

struct EpiIn {
    static constexpr bool PERM = true, AFTER_DRAIN = false;
    int mode; void* out; const rss_t* rowss; rss_t* rowss_v; float qscale;
    __device__ __forceinline__ void operator()(f32x4 (&acc)[2][2][4][2], const Unit& u, int wr, int wc, int fr, int fq) const {
        asm volatile("" : "+v"(fr), "+v"(fq));
        const int row0 = u.pm * BM + wr * 64 + fr;
        if (mode == 0) {
            int colt = u.pn * BM; const int t = colt >> 10; colt &= 1023;
            bf16_t* base = (bf16_t*)out + (size_t)t * ((size_t)MROWS * DM); const float sc = (t == 0) ? qscale : 1.f;
            const int col0 = colt + wc * 32 + 8 * fq;
#pragma unroll
            for (int ai = 0; ai < 2; ++ai)
#pragma unroll
                for (int m = 0; m < 4; ++m) { const int r = row0 + ai * HALF + m * 16; const float rs = rstd_of(rowss[r]) * sc; bf16_t* rowp = base + (size_t)r * DM + col0;
#pragma unroll
                    for (int bj = 0; bj < 2; ++bj) *(u32x4*)(rowp + bj * HALF) = pk8(acc[ai][bj][m][0] * rs, acc[ai][bj][m][1] * rs);
                    asm volatile("" ::: "memory"); }
        } else if (mode == 1) {
            const int col0 = u.pn * BM + wc * 32 + 8 * fq; const bool vpart = u.pn >= 4;
#pragma unroll
            for (int ai = 0; ai < 2; ++ai)
#pragma unroll
                for (int m = 0; m < 4; ++m) { const int r = row0 + ai * HALF + m * 16; const float rs = rstd_of(rowss[r]); bf16_t* rowp = (bf16_t*)out + (size_t)r * 2048 + col0; float sq = 0.f;
#pragma unroll
                    for (int bj = 0; bj < 2; ++bj) { const f32x4 v0 = gelu4(acc[ai][bj][m][0] * rs), v1 = gelu4(acc[ai][bj][m][1] * rs); sq += sumsq4(v0) + sumsq4(v1); *(u32x4*)(rowp + bj * HALF) = pk8(v0, v1); }
                    if (vpart) { sq += __shfl_xor(sq, 16); sq += __shfl_xor(sq, 32); if (fq == 0) rss_add(rowss_v + r, sq); }
                    asm volatile("" ::: "memory"); }
        } else {
            const int col0 = u.pn * BM + wc * 32 + 8 * fq;
#pragma unroll
            for (int ai = 0; ai < 2; ++ai)
#pragma unroll
                for (int m = 0; m < 4; ++m) { const int r = row0 + ai * HALF + m * 16; const float rs = rstd_of(rowss[r]); float* rowp = (float*)out + (size_t)r * DM + col0;
#pragma unroll
                    for (int bj = 0; bj < 2; ++bj) { *(f32x4*)(rowp + bj * HALF) = acc[ai][bj][m][0] * rs; *(f32x4*)(rowp + bj * HALF + 4) = acc[ai][bj][m][1] * rs; }
                    asm volatile("" ::: "memory"); }
        }
    }
};
struct EpiResid {
    static constexpr bool PERM = true, AFTER_DRAIN = false;
    const float* base; float* X; bf16_t* XG; const float* gnext; rss_t* rowss_next; bool GLU; float zs;
    __device__ __forceinline__ void operator()(f32x4 (&acc)[2][2][4][2], const Unit& u, int wr, int wc, int fr, int fq) const {
        asm volatile("" : "+v"(fr), "+v"(fq));
        const int row0 = u.pm * BM + wr * 64 + fr;
        if (!GLU) {
            const int col0 = u.pn * BM + wc * 32 + 8 * fq;
            f32x4 gv[2][2];
#pragma unroll
            for (int bj = 0; bj < 2; ++bj)
#pragma unroll
                for (int n = 0; n < 2; ++n) gv[bj][n] = *(const f32x4*)(gnext + col0 + bj * HALF + 4 * n);
#pragma unroll
            for (int ai = 0; ai < 2; ++ai)
#pragma unroll
                for (int m = 0; m < 4; ++m) { const int r = row0 + ai * HALF + m * 16; float sq = 0.f;
#pragma unroll
                    for (int bj = 0; bj < 2; ++bj) { const size_t off = (size_t)r * DM + col0 + bj * HALF;
                        const f32x4 x0 = *(const f32x4*)(base + off) + acc[ai][bj][m][0] * zs, x1 = *(const f32x4*)(base + off + 4) + acc[ai][bj][m][1] * zs;
                        *(f32x4*)(X + off) = x0; *(f32x4*)(X + off + 4) = x1; *(u32x4*)(XG + off) = pk8(x0 * gv[bj][0], x1 * gv[bj][1]); sq += sumsq4(x0) + sumsq4(x1); }
                    sq += __shfl_xor(sq, 16); sq += __shfl_xor(sq, 32); if (fq == 0) rss_add(rowss_next + r, sq);
                    asm volatile("" ::: "memory"); }
        } else {
            const int col0 = u.pn * HALF + wc * 32 + 8 * fq;
            f32x4 gv[2];
#pragma unroll
            for (int n = 0; n < 2; ++n) gv[n] = *(const f32x4*)(gnext + col0 + 4 * n);
#pragma unroll
            for (int ai = 0; ai < 2; ++ai)
#pragma unroll
                for (int m = 0; m < 4; ++m) { const int r = row0 + ai * HALF + m * 16; float sq = 0.f; const size_t off = (size_t)r * DM + col0; f32x4 xv[2];
#pragma unroll
                    for (int n = 0; n < 2; ++n) { const f32x4 a = acc[ai][0][m][n], g = acc[ai][1][m][n]; f32x4 v;
#pragma unroll
                        for (int e = 0; e < 4; ++e) v[e] = a[e] * sigmoidf_fast(g[e]);
                        xv[n] = *(const f32x4*)(base + off + 4 * n) + v * zs; *(f32x4*)(X + off + 4 * n) = xv[n]; sq += sumsq4(xv[n]); }
                    *(u32x4*)(XG + off) = pk8(xv[0] * gv[0], xv[1] * gv[1]);
                    sq += __shfl_xor(sq, 16); sq += __shfl_xor(sq, 32); if (fq == 0) rss_add(rowss_next + r, sq);
                    asm volatile("" ::: "memory"); }
        }
    }
};
struct EpiUp {
    static constexpr bool PERM = true, AFTER_DRAIN = false;
    bf16_t* ACT; float* EDGE; const rss_t* rowss; const float* cw; const float* cb; PG8_LAS unsigned char* ex;
    __device__ __forceinline__ void operator()(f32x4 (&acc)[2][2][4][2], const Unit& u, int wr, int wc, int fr, int fq) const {
        asm volatile("" : "+v"(fr), "+v"(fq));
        const int row0 = u.pm * BM + wr * 64 + fr;
#pragma unroll
        for (int ai = 0; ai < 2; ++ai)
#pragma unroll
            for (int m = 0; m < 4; ++m) { const float rs = rstd_of(rowss[row0 + ai * HALF + m * 16]);
#pragma unroll
                for (int bj = 0; bj < 2; ++bj)
#pragma unroll
                    for (int n = 0; n < 2; ++n) acc[ai][bj][m][n] = acc[ai][bj][m][n] * rs; }
        PG8_LAS f32x4* EX = (PG8_LAS f32x4*)ex;
        const int slot = ((fr - 14) & 1) * 4 + fq;
        const int ocol = u.pn * HALF + wc * 32 + 8 * fq;
        if (fr >= 14) {
#pragma unroll
            for (int ai = 0; ai < 2; ++ai)
#pragma unroll
                for (int bj = 0; bj < 2; ++bj)
#pragma unroll
                    for (int n = 0; n < 2; ++n) EX[(((((2 * ai + wr) * 4 + wc) * 2 + bj) * 2 + n) * 8) + slot] = acc[ai][bj][3][n];
            if (wr == 1) {
#pragma unroll
                for (int bj = 0; bj < 2; ++bj)
#pragma unroll
                    for (int n = 0; n < 2; ++n) *(f32x4*)(EDGE + (size_t)(u.pm * 4 + 2 + (fr - 14)) * DFF2 + bj * DFF + ocol + 4 * n) = acc[1][bj][3][n];
            }
        }
        if (wr == 0 && fr < 2) {
#pragma unroll
            for (int bj = 0; bj < 2; ++bj)
#pragma unroll
                for (int n = 0; n < 2; ++n) *(f32x4*)(EDGE + (size_t)(u.pm * 4 + fr) * DFF2 + bj * DFF + ocol + 4 * n) = acc[0][bj][0][n];
        }
        asm volatile("s_waitcnt lgkmcnt(0)" ::: "memory"); __builtin_amdgcn_s_barrier(); asm volatile("" ::: "memory");
        const bool bstart = (u.pm & 7) == 0;
#pragma unroll
        for (int n = 0; n < 2; ++n) {
            f32x4 w0[2], w1[2], w2[2], bb[2];
#pragma unroll
            for (int bj = 0; bj < 2; ++bj) { const int oc = bj * DFF + ocol + 4 * n;
                w0[bj] = *(const f32x4*)(cw + oc); w1[bj] = *(const f32x4*)(cw + DFF2 + oc); w2[bj] = *(const f32x4*)(cw + 2 * DFF2 + oc); bb[bj] = *(const f32x4*)(cb + oc); }
#pragma unroll
            for (int ai = 0; ai < 2; ++ai) {
                const int pblk = 2 * ai + wr - 1;
                f32x4 prev[2];
#pragma unroll
                for (int bj = 0; bj < 2; ++bj) prev[bj] = (pblk >= 0) ? EX[((((pblk * 4 + wc) * 2 + bj) * 2 + n) * 8) + slot] : (f32x4){0.f, 0.f, 0.f, 0.f};
#pragma unroll
                for (int m = 0; m < 4; ++m) {
                    f32x4 y[2];
#pragma unroll
                    for (int bj = 0; bj < 2; ++bj) { const f32x4 cur = acc[ai][bj][m][n]; const f32x4 pv = (m == 0) ? prev[bj] : acc[ai][bj][m > 0 ? m - 1 : 0][n];
#pragma unroll
                        for (int e = 0; e < 4; ++e) { const float p1 = dpp_shr1(cur[e]) + dpp_shl15(pv[e]), p2 = dpp_shr2(cur[e]) + dpp_shl14(pv[e]);
                            y[bj][e] = w2[bj][e] * cur[e] + w1[bj][e] * p1 + w0[bj][e] * p2 + bb[bj][e]; } }
                    f32x4 o;
#pragma unroll
                    for (int e = 0; e < 4; ++e) { const float g = y[1][e]; o[e] = g * sigmoidf_fast(g) * y[0][e]; }
                    const bool skip = (ai == 0) && (m == 0) && (wr == 0) && (fr < 2) && !bstart;
                    if (!skip) { u32x2v w; w.x = pkbf(o[0], o[1]); w.y = pkbf(o[2], o[3]); *(u32x2v*)(ACT + (size_t)(row0 + ai * HALF + m * 16) * DFF + ocol + 4 * n) = w; }
                }
                asm volatile("" ::: "memory");
            }
        }
    }
};
}

#define LAS __attribute__((address_space(3)))
typedef unsigned short bf16;
typedef unsigned v4u __attribute__((ext_vector_type(4)));
typedef unsigned v2u __attribute__((ext_vector_type(2)));
typedef float f32x4 __attribute__((ext_vector_type(4)));
typedef float f32x16 __attribute__((ext_vector_type(16)));
typedef short bf16x8 __attribute__((ext_vector_type(8)));
typedef short s16x4 __attribute__((ext_vector_type(4)));
typedef short v4i16_t __attribute__((ext_vector_type(4)));
#define MFMA32(a, b, c) __builtin_amdgcn_mfma_f32_32x32x16_bf16((a), (b), (c), 0, 0, 0)
#define MFMA16(a, b, c) __builtin_amdgcn_mfma_f32_16x16x32_bf16((a), (b), (c), 0, 0, 0)
constexpr int NWAVES = 8;
constexpr int M = 16384, D = 1024, SEQ = 2048, FF = 2816, FF2 = 5632;
constexpr size_t MiB = 1u << 20;
constexpr size_t WS_RS = 0;
constexpr size_t WS_WQKV = 2 * MiB, WS_WO = 14 * MiB, WS_SGIN = 18 * MiB, WS_SGO = 22 * MiB, WS_SSMIN = 24 * MiB, WS_GLU = 26 * MiB, WS_UP = 30 * MiB, WS_DOWN = 74 * MiB;
constexpr size_t WS_XG = 96 * MiB, WS_EDGE = 128 * MiB, WS_BIG = 134 * MiB, WS_END = 230 * MiB;
constexpr int RING_BYTES = 131072, EX_OFF = RING_BYTES, LDS_BYTES = 147456;
constexpr float QSCALE = 0.125f * 1.4426950408889634f;

__device__ __forceinline__ float wave_sum(float v) {
#pragma unroll
    for (int o = 1; o < 64; o <<= 1) v += __shfl_xor(v, o);
    return v;
}
__device__ __forceinline__ unsigned pk2(float lo, float hi) { return pg8::pkbf(lo, hi); }
__device__ __forceinline__ bf16x8 pack8(const float* v) { v4u w; w.x = pk2(v[0], v[1]); w.y = pk2(v[2], v[3]); w.z = pk2(v[4], v[5]); w.w = pk2(v[6], v[7]); return __builtin_bit_cast(bf16x8, w); }
__device__ __forceinline__ float bf_lo(unsigned w) { return __builtin_bit_cast(float, w << 16); }
__device__ __forceinline__ float bf_hi(unsigned w) { return __builtin_bit_cast(float, w & 0xffff0000u); }
__device__ __forceinline__ s16x4 vtr(LAS const unsigned char* p) { return __builtin_bit_cast(s16x4, __builtin_amdgcn_ds_read_tr16_b64_v4i16((LAS v4i16_t*)p)); }
__device__ __forceinline__ int crow(int i, int h) { return (i & 3) + 8 * (i >> 2) + 4 * h; }

__device__ __forceinline__ void transpose_item(const float* W, int K, int N, bf16* WT, int half, LAS float* scr, int item, int lane) {
    const int nblk = N / 32, kb = item / nblk, nb = item % nblk, k0 = 64 * kb, n0 = 32 * nb;
    int d0 = n0; if (half > 0) { const int cc = n0 % half; d0 = 256 * (cc / 128) + 128 * (n0 / half) + (cc % 128); }
#pragma unroll 8
    for (int i = 0; i < 32; ++i) { const int kk = 2 * i + (lane >> 5); scr[kk * 33 + (lane & 31)] = W[(size_t)(k0 + kk) * N + n0 + (lane & 31)]; }
    asm volatile("s_waitcnt lgkmcnt(0)" ::: "memory");
    const int c = lane & 7;
#pragma unroll
    for (int j = 0; j < 4; ++j) { const int n = (lane >> 3) + 8 * j; const LAS float* s = scr + (8 * c) * 33 + n;
        v4u o; o.x = pk2(s[0 * 33], s[1 * 33]); o.y = pk2(s[2 * 33], s[3 * 33]); o.z = pk2(s[4 * 33], s[5 * 33]); o.w = pk2(s[6 * 33], s[7 * 33]);
        *(v4u*)(WT + (size_t)(d0 + n) * K + k0 + 8 * c) = o; }
    asm volatile("s_waitcnt lgkmcnt(0)" ::: "memory");
}
__device__ __forceinline__ void convert_matrix(const float* W, int K, int N, bf16* WT, int half, LAS float* scr, int gw, int ngw, int lane) {
    const int items = (K / 64) * (N / 32);
    for (int it = gw; it < items; it += ngw) transpose_item(W, K, N, WT, half, scr, it, lane);
}

__device__ __forceinline__ void attn_phase(const bf16* Qb, const bf16* Kb, const bf16* Vb, bf16* Ob, LAS unsigned char* vbuf, int gwave, int ngw, int lane) {
    asm volatile("" : "+v"(lane));
    const int r = lane & 31, h = lane >> 5, i16 = lane & 15, g16 = lane >> 4, tq = i16 >> 2, tp = i16 & 3;
    const int troff = tq * 144 + (16 * (g16 & 1)) * 2 + 8 * tp;
    for (int unit = gwave; unit < 8192; unit += ngw) {
        const int qb = unit & 63, bh = unit >> 6, hd = bh & 15; const size_t rowbase = (size_t)(bh >> 4) * SEQ;
        const bf16* qp = Qb + (rowbase + qb * 32 + r) * D + hd * 64 + 8 * h;
        bf16x8 qf[4];
#pragma unroll
        for (int kk = 0; kk < 4; ++kk) qf[kk] = *(const bf16x8*)(qp + 16 * kk);
        f32x16 o0, o1;
#pragma unroll
        for (int i = 0; i < 16; ++i) { o0[i] = 0.f; o1[i] = 0.f; }
        float srow = 0.f;
        for (int kt = qb; kt >= 0; --kt) {
            const bf16* kp = Kb + (rowbase + kt * 32 + r) * D + hd * 64 + 8 * h;
            bf16x8 kf[4];
#pragma unroll
            for (int kk = 0; kk < 4; ++kk) kf[kk] = *(const bf16x8*)(kp + 16 * kk);
#pragma unroll
            for (int i = 0; i < 4; ++i) { const int row = (lane >> 3) + 8 * i, ch = lane & 7;
                const v4u vv = *(const v4u*)(Vb + (rowbase + kt * 32 + row) * D + hd * 64 + ch * 8);
                *(LAS v4u*)(vbuf + row * 144 + ch * 16) = vv; }
            f32x16 x;
#pragma unroll
            for (int i = 0; i < 16; ++i) x[i] = 0.f;
#pragma unroll
            for (int kk = 0; kk < 4; ++kk) x = MFMA32(kf[kk], qf[kk], x);
            const bool diag = (kt == qb);
            float lb[16], l1[16];
#pragma unroll
            for (int i = 0; i < 16; ++i) {
                const float z = x[i];
                const float e = __builtin_amdgcn_exp2f(-fabsf(z));
                const float sp = fmaxf(z, 0.f) + __builtin_amdgcn_logf(1.0f + e);
                float l1m = -sp, lbv = z - sp;
                if (diag) { const bool valid = crow(i, h) < r; l1m = valid ? l1m : 0.f; lbv = valid ? lbv : -INFINITY; }
                l1[i] = l1m; lb[i] = lbv;
            }
            float within[16], gown[4], goth[4];
#pragma unroll
            for (int q = 0; q < 4; ++q) { const float w3 = l1[4 * q + 3], w2 = w3 + l1[4 * q + 2], w1 = w2 + l1[4 * q + 1];
                within[4 * q + 3] = 0.f; within[4 * q + 2] = w3; within[4 * q + 1] = w2; within[4 * q] = w1; gown[q] = w1 + l1[4 * q]; }
#pragma unroll
            for (int q = 0; q < 4; ++q) goth[q] = __shfl_xor(gown[q], 32);
            const float T0 = gown[0] + goth[0], T1 = gown[1] + goth[1], T2 = gown[2] + goth[2], T3 = gown[3] + goth[3];
            float after[4]; after[3] = 0.f; after[2] = T3; after[1] = T3 + T2; after[0] = after[1] + T1;
            float w[16];
#pragma unroll
            for (int q = 0; q < 4; ++q) { const float basec = srow + after[q] + (h == 0 ? goth[q] : 0.f);
#pragma unroll
                for (int e = 0; e < 4; ++e) w[4 * q + e] = __builtin_amdgcn_exp2f(lb[4 * q + e] + basec + within[4 * q + e]); }
            srow += after[0] + T0;
            const bf16x8 pf0 = pack8(w), pf1 = pack8(w + 8);
            asm volatile("s_waitcnt lgkmcnt(0)" ::: "memory");
#pragma unroll
            for (int s = 0; s < 2; ++s) {
                const bf16x8 pf = s ? pf1 : pf0;
#pragma unroll
                for (int db = 0; db < 2; ++db) {
                    const s16x4 lo = vtr(vbuf + (16 * s + 4 * h) * 144 + 64 * db + troff), hi = vtr(vbuf + (16 * s + 8 + 4 * h) * 144 + 64 * db + troff);
                    const bf16x8 a = __builtin_shufflevector(lo, hi, 0, 1, 2, 3, 4, 5, 6, 7);
                    if (db == 0) o0 = MFMA32(a, pf, o0); else o1 = MFMA32(a, pf, o1);
                }
            }
            asm volatile("s_waitcnt lgkmcnt(0)" ::: "memory");
            if (__all(srow < -160.0f)) break;
        }
        bf16* op = Ob + (rowbase + qb * 32 + r) * D + hd * 64 + 4 * h;
#pragma unroll
        for (int g = 0; g < 4; ++g) {
            v2u a; a.x = pk2(o0[4 * g], o0[4 * g + 1]); a.y = pk2(o0[4 * g + 2], o0[4 * g + 3]); *(v2u*)(op + 8 * g) = a;
            v2u b; b.x = pk2(o1[4 * g], o1[4 * g + 1]); b.y = pk2(o1[4 * g + 2], o1[4 * g + 3]); *(v2u*)(op + 32 + 8 * g) = b;
        }
    }
}

__device__ __forceinline__ void sg_phase(const bf16* H, const pg8::rss_t* rowss_v, const float* vg, const float* Ws, const float* bs, bf16* GATED, LAS unsigned char* lds, int G, int bid, int tid) {
    asm volatile("" : "+v"(tid));
    const int wave = tid >> 6, lane = tid & 63, tb = wave & 3, dh = wave >> 2;
    const int r = lane & 31, h = lane >> 5, i16 = lane & 15, g16 = lane >> 4, tq = i16 >> 2, tp = i16 & 3;
    const int troff = tq * 272 + (16 * (g16 & 1)) * 2 + 8 * tp;
    for (int unit = bid; unit < 1024; unit += G) {
        const int g = unit & 7; const size_t rowbase = (size_t)(unit >> 3) * 128;
#pragma unroll
        for (int i = 0; i < 4; ++i) { const int s = (tid >> 4) + 32 * i, ch = tid & 15; const size_t row = rowbase + s;
            const v4u raw = *(const v4u*)(H + row * 2048 + 1024 + g * 128 + ch * 8); const float rs = pg8::rstd_of(rowss_v[row]);
            const f32x4 g0 = *(const f32x4*)(vg + g * 128 + ch * 8), g1 = *(const f32x4*)(vg + g * 128 + ch * 8 + 4);
            v4u o; o.x = pk2(bf_lo(raw.x) * rs * g0[0], bf_hi(raw.x) * rs * g0[1]); o.y = pk2(bf_lo(raw.y) * rs * g0[2], bf_hi(raw.y) * rs * g0[3]);
            o.z = pk2(bf_lo(raw.z) * rs * g1[0], bf_hi(raw.z) * rs * g1[1]); o.w = pk2(bf_lo(raw.w) * rs * g1[2], bf_hi(raw.w) * rs * g1[3]);
            *(LAS v4u*)(lds + s * 272 + ch * 16) = o; }
        __syncthreads();
        const int t = 32 * tb + r;
        f32x16 a0, a1;
#pragma unroll
        for (int i = 0; i < 16; ++i) { a0[i] = 0.f; a1[i] = 0.f; }
        for (int kk = 0; kk <= 2 * tb + 1; ++kk) {
            const int sb = 16 * kk + 8 * h; const float* wp = Ws + ((size_t)(g * 128 + t) * 128 + sb);
            const f32x4 w0 = *(const f32x4*)wp, w1 = *(const f32x4*)(wp + 4); float wv[8];
#pragma unroll
            for (int j = 0; j < 4; ++j) { wv[j] = (sb + j <= t) ? w0[j] : 0.f; wv[4 + j] = (sb + 4 + j <= t) ? w1[j] : 0.f; }
            const bf16x8 bfr = pack8(wv);
#pragma unroll
            for (int db = 0; db < 2; ++db) { const int dbk = 2 * dh + db;
                const s16x4 lo = vtr(lds + (16 * kk + 8 * h) * 272 + 64 * dbk + troff), hi = vtr(lds + (16 * kk + 8 * h + 4) * 272 + 64 * dbk + troff);
                const bf16x8 a = __builtin_shufflevector(lo, hi, 0, 1, 2, 3, 4, 5, 6, 7);
                if (db == 0) a0 = MFMA32(a, bfr, a0); else a1 = MFMA32(a, bfr, a1); }
        }
        const size_t row = rowbase + t; const float bias = bs[g * 128 + t];
#pragma unroll
        for (int db = 0; db < 2; ++db)
#pragma unroll
            for (int gq = 0; gq < 4; ++gq) { const int d0 = 32 * (2 * dh + db) + 8 * gq + 4 * h;
                const v2u ur = *(const v2u*)(H + row * 2048 + g * 128 + d0);
                const float s0 = (db ? a1[4 * gq] : a0[4 * gq]) + bias, s1 = (db ? a1[4 * gq + 1] : a0[4 * gq + 1]) + bias, s2 = (db ? a1[4 * gq + 2] : a0[4 * gq + 2]) + bias, s3 = (db ? a1[4 * gq + 3] : a0[4 * gq + 3]) + bias;
                v2u o; o.x = pk2(bf_lo(ur.x) * s0, bf_hi(ur.x) * s1); o.y = pk2(bf_lo(ur.y) * s2, bf_hi(ur.y) * s3);
                *(v2u*)(GATED + row * D + g * 128 + d0) = o; }
        __syncthreads();
    }
}

__device__ __forceinline__ void sincos_cw(float x, float& s, float& c) {
    const float k = rintf(x * 0.6366197723675814f);
    float rr = fmaf(-k, 1.5707963705062866f, x); rr = fmaf(-k, -4.371139000186243e-08f, rr);
    const int q = ((int)k) & 3; const float r2 = rr * rr;
    const float sp = rr + rr * r2 * (-1.6666667163e-1f + r2 * (8.3333337680e-3f + r2 * (-1.9841270114e-4f + r2 * 2.7557314297e-6f)));
    const float cp = 1.f + r2 * (-0.5f + r2 * (4.1666667908e-2f + r2 * (-1.3888889225e-3f + r2 * (2.4801587642e-5f + r2 * (-2.7557319224e-7f)))));
    s = (q == 0) ? sp : (q == 1) ? cp : (q == 2) ? -sp : -cp;
    c = (q == 0) ? cp : (q == 1) ? -sp : (q == 2) ? -cp : sp;
}
__device__ __forceinline__ void ssm_phase(const float* U, const float* lam_re, const float* lam_im, const float* log_dt, const float* b_re, const float* b_im, const float* c_re, const float* c_im,
                                          const float* d_skip, bf16* Y, LAS unsigned char* ldsw, int item0, int istride, int lane) {
    asm volatile("" : "+v"(lane));
    const int r = lane & 31, hh = lane >> 5, hc = lane & 15, fq = lane >> 4;
    LAS float* BU = (LAS float*)ldsw; LAS unsigned short* XB = (LAS unsigned short*)ldsw;
    for (int item = item0; item < 512; item += istride) {
        const int b = item >> 6, g = item & 63;
        const float lr = fminf(lam_re[g * 64 + lane], -1e-4f), li = lam_im[g * 64 + lane], dt = expf(log_dt[g]), mag = expf(dt * lr);
        float sn, cs; sincos_cw(dt * li, sn, cs);
        const float ar = mag * cs, ai = mag * sn, den = lr * lr + li * li;
        const float cre = ((ar - 1.0f) * lr + ai * li) / den, cim = (ai * lr - (ar - 1.0f) * li) / den;
        bf16x8 bfre[2], bfim[2];
#pragma unroll
        for (int pb = 0; pb < 2; ++pb) { const int pp = 32 * pb + r; const float cr = __shfl(cre, pp), ci = __shfl(cim, pp);
            const float* brp = b_re + ((size_t)(g * 64 + pp) * 16 + 8 * hh); const float* bip = b_im + ((size_t)(g * 64 + pp) * 16 + 8 * hh);
            const f32x4 br0 = *(const f32x4*)brp, br1 = *(const f32x4*)(brp + 4), bi0 = *(const f32x4*)bip, bi1 = *(const f32x4*)(bip + 4);
            float re[8], im[8];
#pragma unroll
            for (int j = 0; j < 4; ++j) { re[j] = cr * br0[j] - ci * bi0[j]; im[j] = cr * bi0[j] + ci * br0[j]; re[4 + j] = cr * br1[j] - ci * bi1[j]; im[4 + j] = cr * bi1[j] + ci * br1[j]; }
            bfre[pb] = pack8(re); bfim[pb] = pack8(im); }
        bf16x8 cf[4];
#pragma unroll
        for (int kk = 0; kk < 4; ++kk) { const int kx0 = 32 * kk + 8 * fq; const float* src = (kk < 2) ? (c_re + ((size_t)(g * 16 + hc) * 64 + kx0)) : (c_im + ((size_t)(g * 16 + hc) * 64 + kx0 - 64));
            const f32x4 c0 = *(const f32x4*)src, c1 = *(const f32x4*)(src + 4); const float sg = (kk < 2) ? 1.f : -1.f; float cv[8];
#pragma unroll
            for (int j = 0; j < 4; ++j) { cv[j] = sg * c0[j]; cv[4 + j] = sg * c1[j]; }
            cf[kk] = pack8(cv); }
        const f32x4 dsk = *(const f32x4*)(d_skip + g * 16 + 4 * fq);
        float xr = 0.f, xi = 0.f;
        for (int sub = 0; sub < 64; ++sub) {
            const size_t t0 = (size_t)b * SEQ + sub * 32;
            const float* up = U + (t0 + r) * D + g * 16 + 8 * hh;
            const f32x4 u0 = *(const f32x4*)up, u1 = *(const f32x4*)(up + 4); float uv[8];
#pragma unroll
            for (int j = 0; j < 4; ++j) { uv[j] = u0[j]; uv[4 + j] = u1[j]; }
            const bf16x8 uf = pack8(uv);
            f32x16 zero;
#pragma unroll
            for (int i = 0; i < 16; ++i) zero[i] = 0.f;
#pragma unroll
            for (int xb = 0; xb < 4; ++xb) { const f32x16 d = MFMA32(uf, (xb == 0 ? bfre[0] : xb == 1 ? bfre[1] : xb == 2 ? bfim[0] : bfim[1]), zero);
#pragma unroll
                for (int i = 0; i < 16; ++i) BU[crow(i, hh) * 128 + 32 * xb + r] = d[i]; }
            asm volatile("s_waitcnt lgkmcnt(0)" ::: "memory");
#pragma unroll 8
            for (int t = 0; t < 32; ++t) { const float br = BU[t * 128 + lane], bi = BU[t * 128 + 64 + lane];
                const float nxr = fmaf(ar, xr, fmaf(-ai, xi, br)), nxi = fmaf(ar, xi, fmaf(ai, xr, bi)); xr = nxr; xi = nxi;
                const unsigned pkd = pk2(xr, xi); XB[t * 256 + lane] = (unsigned short)(pkd & 0xffffu); XB[t * 256 + 64 + lane] = (unsigned short)(pkd >> 16); }
            asm volatile("s_waitcnt lgkmcnt(0)" ::: "memory");
#pragma unroll
            for (int tb = 0; tb < 2; ++tb) { f32x4 acc = {0.f, 0.f, 0.f, 0.f};
#pragma unroll
                for (int kk = 0; kk < 4; ++kk) { const bf16x8 xf = *(const LAS bf16x8*)(ldsw + (16 * tb + hc) * 512 + (32 * kk + 8 * fq) * 2); acc = MFMA16(cf[kk], xf, acc); }
                const size_t row = t0 + 16 * tb + hc; const f32x4 u4 = *(const f32x4*)(U + row * D + g * 16 + 4 * fq);
                const f32x4 y = pg8::gelu4(acc + dsk * u4);
                v2u o; o.x = pk2(y[0], y[1]); o.y = pk2(y[2], y[3]); *(v2u*)(Y + row * D + g * 16 + 4 * fq) = o; }
            asm volatile("s_waitcnt lgkmcnt(0)" ::: "memory");
        }
    }
}

__device__ __forceinline__ void ffn_fixup(const pg8::StaticOrder& S, const float* EDGE, const float* cw, const float* cb, bf16* ACT, int tid) {
    asm volatile("" : "+v"(tid));
    pg8::Unit u;
    for (int i = 0; S.next(i, u); ++i) {
        const int pm = u.pm; if ((pm & 7) == 0) continue;
        const float* L0 = EDGE + (size_t)((pm - 1) * 4 + 2) * FF2; const float* L1 = L0 + FF2; const float* F0 = EDGE + (size_t)(pm * 4) * FF2; const float* F1 = F0 + FF2;
        for (int idx = tid; idx < 2 * FF; idx += NWAVES * 64) { const int rr = idx / FF, c = idx - rr * FF; float y[2];
#pragma unroll
            for (int bj = 0; bj < 2; ++bj) { const int oc = bj * FF + c; const float w0 = cw[oc], w1 = cw[FF2 + oc], w2 = cw[2 * FF2 + oc], bb = cb[oc];
                y[bj] = (rr == 0) ? (w0 * L0[oc] + w1 * L1[oc] + w2 * F0[oc] + bb) : (w0 * L1[oc] + w1 * F0[oc] + w2 * F1[oc] + bb); }
            const float o = y[1] * pg8::sigmoidf_fast(y[1]) * y[0];
            ACT[(size_t)(pm * 256 + rr) * FF + c] = (bf16)(pk2(o, o) & 0xffffu); }
    }
    asm volatile("s_waitcnt vmcnt(0)" ::: "memory");
    __syncthreads();
}

#define GRID_SYNC() do { asm volatile("s_waitcnt vmcnt(0)" ::: "memory"); __syncthreads(); \
    if (threadIdx.x == 0) { asm volatile("buffer_wbl2 sc1\n\ts_waitcnt vmcnt(0)" ::: "memory"); } \
    grid.sync(); asm volatile("buffer_inv sc1\n\ts_waitcnt vmcnt(0)" ::: "memory"); } while (0)
struct Args { const float* in[24]; float* out; unsigned char* ws; float zs[20]; };
enum { I_X = 0, I_NORMG, I_FNG, I_WQKV, I_WO, I_SGIN, I_SGNG, I_SGWS, I_SGB, I_SGO, I_SSMIN, I_LRE, I_LIM, I_LDT, I_BRE, I_BIM, I_CRE, I_CIM, I_SSMD, I_GLU, I_UP, I_CONVW, I_CONVB, I_DOWN };

__global__ void __launch_bounds__(NWAVES * 64, 2) trunk_fwd(Args args) {
    extern __shared__ __attribute__((aligned(16))) unsigned char lds_raw[];
    cg::grid_group grid = cg::this_grid();
    LAS unsigned char* lds = (LAS unsigned char*)lds_raw;
    const int tid = threadIdx.x, lane = tid & 63, wave = __builtin_amdgcn_readfirstlane(tid >> 6);
    const int G = gridDim.x, bid0 = blockIdx.x, gw0 = bid0 * NWAVES + wave, ngw = G * NWAVES;
    unsigned char* ws = args.ws;
    pg8::rss_t* RS = (pg8::rss_t*)(ws + WS_RS);
    bf16* WQKV_T = (bf16*)(ws + WS_WQKV); bf16* WO_T = (bf16*)(ws + WS_WO); bf16* SGIN_T = (bf16*)(ws + WS_SGIN); bf16* SGO_T = (bf16*)(ws + WS_SGO);
    bf16* SSMIN_T = (bf16*)(ws + WS_SSMIN); bf16* GLU_T = (bf16*)(ws + WS_GLU); bf16* UP_T = (bf16*)(ws + WS_UP); bf16* DOWN_T = (bf16*)(ws + WS_DOWN);
    bf16* XG = (bf16*)(ws + WS_XG); float* EDGE = (float*)(ws + WS_EDGE); unsigned char* BIG = ws + WS_BIG;
    float* X = args.out;
    const float* x_in = args.in[I_X]; const float* norm_g = args.in[I_NORMG];

    {
        for (int i = bid0 * (NWAVES * 64) + tid; i < 9 * M; i += G * NWAVES * 64) RS[M + i] = 0ull;
        LAS float* scr = (LAS float*)(lds + wave * 16384);
        for (int j = 0; j < 2; ++j) {
            convert_matrix(args.in[I_WQKV] + (size_t)j * D * 3 * D, D, 3 * D, WQKV_T + (size_t)j * 3 * D * D, 0, scr, gw0, ngw, lane);
            convert_matrix(args.in[I_WO] + (size_t)j * D * D, D, D, WO_T + (size_t)j * D * D, 0, scr, gw0, ngw, lane);
        }
        convert_matrix(args.in[I_SGIN], D, 2 * D, SGIN_T, 0, scr, gw0, ngw, lane);
        convert_matrix(args.in[I_SGO], D, D, SGO_T, 0, scr, gw0, ngw, lane);
        convert_matrix(args.in[I_SSMIN], D, D, SSMIN_T, 0, scr, gw0, ngw, lane);
        convert_matrix(args.in[I_GLU], D, 2 * D, GLU_T, D, scr, gw0, ngw, lane);
        for (int i = 0; i < 4; ++i) {
            convert_matrix(args.in[I_UP] + (size_t)i * D * FF2, D, FF2, UP_T + (size_t)i * FF2 * D, FF, scr, gw0, ngw, lane);
            convert_matrix(args.in[I_DOWN] + (size_t)i * FF * D, FF, D, DOWN_T + (size_t)i * D * FF, 0, scr, gw0, ngw, lane);
        }
        for (int m = gw0; m < M; m += ngw) {
            const f32x4* xr = (const f32x4*)(x_in + (size_t)m * D) + lane; const f32x4* gr = (const f32x4*)norm_g + lane; float s = 0.f;
            v2u* o = (v2u*)(XG + (size_t)m * D) + lane;
#pragma unroll
            for (int j = 0; j < 4; ++j) { const f32x4 v = xr[64 * j], g = gr[64 * j]; s += pg8::sumsq4(v); v2u w; w.x = pk2(v[0] * g[0], v[1] * g[1]); w.y = pk2(v[2] * g[2], v[3] * g[3]); o[64 * j] = w; }
            s = wave_sum(s); if (lane == 0) RS[m] = pg8::rss_of(s);
        }
    }
    GRID_SYNC();

    for (int step = 0; step < 20; ++step) {
        int bid = (int)blockIdx.x; asm volatile("" : "+s"(bid));
        const int layer = step / 5, sub = step - layer * 5, mixer = layer % 3, j = layer / 3;
        const int gw = bid * NWAVES + wave;
        pg8::rss_t* rs_mid = RS + (size_t)(2 * layer + 1) * M;
        if (sub == 0) {
            const pg8::rss_t* rs_in = RS + (size_t)(2 * layer) * M;
            const bf16* Bt = (mixer == 0) ? WQKV_T + (size_t)j * 3 * D * D : (mixer == 1) ? SGIN_T : SSMIN_T; const int N = (mixer == 0) ? 3 * D : (mixer == 1) ? 2 * D : D;
            pg8::Gemm g{XG, Bt, M, N, D}; pg8::StaticOrder S; S.init(M, N, G, bid);
            pg8::EpiIn E{mixer, (void*)BIG, rs_in, RS + (size_t)9 * M, QSCALE};
#ifndef SKIP_GIN
            pg8::gemm_phase<pg8::EpiIn, pg8::StaticOrder, true, true>(lds, g, S, E);
#endif
        } else if (sub == 1) {
            if (mixer == 0) { bf16* Qb = (bf16*)BIG; bf16* Kb = Qb + (size_t)M * D; bf16* Vb = Kb + (size_t)M * D;
#ifndef SKIP_ATT
                attn_phase(Qb, Kb, Vb, Qb, lds + wave * 4608, gw, ngw, lane);
#endif
            } else if (mixer == 1) { bf16* Hb = (bf16*)BIG; bf16* GATED = Hb + (size_t)M * 2 * D;
#ifndef SKIP_SG
                sg_phase(Hb, RS + (size_t)9 * M, args.in[I_SGNG], args.in[I_SGWS], args.in[I_SGB], GATED, lds, G, bid, tid);
#endif
            } else { float* Ub = (float*)BIG; bf16* Yb = (bf16*)(BIG + (size_t)M * D * 4);
#ifndef SKIP_SSM
                if (wave < 2) ssm_phase(Ub, args.in[I_LRE], args.in[I_LIM], args.in[I_LDT], args.in[I_BRE], args.in[I_BIM], args.in[I_CRE], args.in[I_CIM], args.in[I_SSMD], Yb, lds + wave * 16384, bid * 2 + wave, G * 2, lane);
#endif
            }
        } else if (sub == 3) {
            const float* cw = args.in[I_CONVW] + (size_t)layer * 3 * FF2; const float* cb = args.in[I_CONVB] + (size_t)layer * FF2;
            pg8::Gemm g{XG, UP_T + (size_t)layer * FF2 * D, M, FF2, D}; pg8::StaticOrder S; S.init(M, FF2, G, bid);
            pg8::EpiUp E{(bf16*)BIG, EDGE, rs_mid, cw, cb, lds + EX_OFF};
#ifndef SKIP_UP
            pg8::gemm_phase<pg8::EpiUp, pg8::StaticOrder, true, true>(lds, g, S, E);
#endif
        } else {
            const bool down = (sub == 4);
            const bf16* A = down ? (const bf16*)BIG : (mixer == 0) ? (const bf16*)BIG : (mixer == 1) ? (const bf16*)BIG + (size_t)M * 2 * D : (const bf16*)(BIG + (size_t)M * D * 4);
            const bf16* Bt = down ? DOWN_T + (size_t)layer * D * FF : (mixer == 0) ? WO_T + (size_t)j * D * D : (mixer == 1) ? SGO_T : GLU_T;
            const bool glu = !down && mixer == 2; const int N = glu ? 2 * D : D, K = down ? FF : D;
            const float* gn = down ? ((layer < 3) ? norm_g + (size_t)((layer + 1) * 2) * D : args.in[I_FNG]) : norm_g + (size_t)(layer * 2 + 1) * D;
            pg8::rss_t* rsn = down ? RS + (size_t)(2 * layer + 2) * M : rs_mid;
            const float* xbase = (layer == 0 && !down) ? x_in : X;
            pg8::Gemm g{A, Bt, M, N, K}; pg8::StaticOrder S; S.init(M, N, G, bid);
            if (down) ffn_fixup(S, EDGE, args.in[I_CONVW] + (size_t)layer * 3 * FF2, args.in[I_CONVB] + (size_t)layer * FF2, (bf16*)BIG, tid);

            const float zs = args.zs[step];
            pg8::EpiResid E{xbase, X, XG, gn, rsn, glu, zs};
#ifndef SKIP_RES
            pg8::gemm_phase<pg8::EpiResid, pg8::StaticOrder, true, true>(lds, g, S, E);
#endif
        }
        GRID_SYNC();
    }
    {
        const f32x4* gr = (const f32x4*)args.in[I_FNG] + lane;
        for (int m = gw0; m < M; m += ngw) {
            f32x4* xr = (f32x4*)(X + (size_t)m * D) + lane; f32x4 v[4]; float s = 0.f;
#pragma unroll
            for (int jj = 0; jj < 4; ++jj) { v[jj] = xr[64 * jj]; s += pg8::sumsq4(v[jj]); }
            const float rs = rsqrtf(wave_sum(s) * (1.0f / 1024.0f) + pg8::RMS_EPS);
#pragma unroll
            for (int jj = 0; jj < 4; ++jj) xr[64 * jj] = v[jj] * rs * gr[64 * jj];
        }
    }
}

extern "C" void kernel_launch(void* const* d_in, const int* in_sizes, int n_in, void* d_out, int out_size, void* d_ws, size_t ws_size, hipStream_t stream) {
    static int grid = 0;
    if (grid == 0) {
        if (n_in != 24 || out_size != M * D || ws_size < WS_END) { fprintf(stderr, "kernel_launch: unexpected problem (n_in %d, out %d, ws %zu)\n", n_in, out_size, ws_size); grid = -1; return; }
        int dev = 0, cus = 0, per_cu = 0;
        hipGetDevice(&dev); hipDeviceGetAttribute(&cus, hipDeviceAttributeMultiprocessorCount, dev);
        if (hipFuncSetAttribute((const void*)trunk_fwd, hipFuncAttributeMaxDynamicSharedMemorySize, LDS_BYTES) != hipSuccess) { fprintf(stderr, "kernel_launch: hipFuncSetAttribute failed\n"); grid = -1; return; }
        if (hipOccupancyMaxActiveBlocksPerMultiprocessor(&per_cu, (const void*)trunk_fwd, NWAVES * 64, LDS_BYTES) != hipSuccess || per_cu < 1) per_cu = 1;
        (void)hipGetLastError();
        grid = cus * 1;
        if (grid <= 0) grid = 256;
    }
    if (grid < 0) return;
    Args a{};
    for (int i = 0; i < 24; ++i) a.in[i] = (const float*)d_in[i];
    a.out = (float*)d_out; a.ws = (unsigned char*)d_ws;
    { const int on[20] = DBG_ON; for (int i = 0; i < 20; ++i) a.zs[i] = on[i] ? 1.f : 0.f; }
    void* kargs[] = {&a};
    hipError_t e = hipLaunchCooperativeKernel((const void*)trunk_fwd, dim3(grid), dim3(NWAVES * 64), kargs, LDS_BYTES, stream);
    if (e != hipSuccess) fprintf(stderr, "kernel_launch: cooperative launch failed: %s (grid %d)\n", hipGetErrorString(e), grid);
}
```

```cpp
#include <hip/hip_runtime.h>
#include <hip/hip_cooperative_groups.h>
#include <cstdio>
#include <cstdint>
namespace cg = cooperative_groups;
namespace pg8 {
#define PG8_LAS __attribute__((address_space(3)))
typedef unsigned short bf16_t;
typedef short bf16x8 __attribute__((ext_vector_type(8)));
typedef float f32x4 __attribute__((ext_vector_type(4)));
typedef unsigned u32x4 __attribute__((ext_vector_type(4)));
constexpr int BM = 256, BK = 64, HALF = 128, HTB = HALF * BK * 2  , STAGE_BYTES = 8 * HTB, NXCD = 8, WGM = 8;

__host__ __device__ __forceinline__ int lds_byte(int r, int c) { const int st = (r >> 4) * 2 + (c >> 5), rr = r & 15, cc = c & 31, ob = rr * 64 + cc * 2; return st * 1024 + (ob ^ (((ob >> 9) & 1) << 5)); }
__host__ __device__ __forceinline__ void stage_rc(int b, int& R, int& C) { const int st = b / 1024, sb = b % 1024, swz = sb ^ (((sb >> 9) & 1) << 5); R = (st >> 1) * 16 + swz / 64; C = (st & 1) * 32 + (swz % 64) / 2; }
__host__ __device__ __forceinline__ int perm32(int rho) { const int n = rho >> 4, i = rho & 15; return 8 * (i >> 2) + 4 * n + (i & 3); }

struct Unit { int pm, pn; };
struct Gemm { const bf16_t* A; const bf16_t* Bt; int M, N, K; };

struct StaticOrder {
    int nM, nN, nwg, G, c;
    __host__ __device__ void init(int M, int N, int G_, int c_) { nM = M / BM; nN = N / BM; nwg = nM * nN; G = G_; c = c_; }
    __host__ __device__ bool next(int i, Unit& u) const {
        const long L = (long)i * G + c; if (L >= nwg) return false;
        int wgid = (int)L; { const int q = nwg / NXCD, r = nwg % NXCD, xcd = wgid % NXCD, off = wgid / NXCD; wgid = (xcd < r ? xcd * (q + 1) : r * (q + 1) + (xcd - r) * q) + off; }
        const int nig = WGM * nN, gid = wgid / nig, fm = gid * WGM, gsz = (nM - fm) < WGM ? (nM - fm) : WGM;
        u.pm = fm + ((wgid % nig) % gsz); u.pn = (wgid % nig) / gsz; return true;
    }
    __device__ __forceinline__ void a_ready(const Unit&) const {}
    __device__ __forceinline__ void done(const Unit&) const {}
};

__device__ __forceinline__ unsigned cvt_pk_bf16(float lo, float hi) { unsigned r; asm volatile("v_cvt_pk_bf16_f32 %0, %1, %2" : "=v"(r) : "v"(lo), "v"(hi)); return r; }
template <class Epi, class Sched, bool ALIGN_EPI = false, bool SP2 = false>
__device__ __forceinline__ void gemm_phase(PG8_LAS unsigned char* lds, const Gemm g, const Sched& S, const Epi& E) {
    int tid = threadIdx.x; asm volatile("" : "+v"(tid));
    const int wid = __builtin_amdgcn_readfirstlane(tid >> 6), lane = tid & 63, wr = wid >> 2, wc = wid & 3, fr = lane & 15, fq = lane >> 4;
    const int K = g.K, nt = K / BK;
    unsigned voffA[2], voffB[2];
#pragma unroll
    for (int i = 0; i < 2; ++i) { int R, C; stage_rc(tid * 16 + i * 8192, R, C); const int Rb = Epi::PERM ? ((R & ~31) + perm32(R & 31)) : R;
        voffA[i] = (unsigned)(R * K + C) * 2u; voffB[i] = (unsigned)(Rb * K + C) * 2u; }
    const size_t kstep = (size_t)(BK * 2);
    const size_t hstep = (size_t)HALF * K * 2;
    const size_t tstep = 2 * hstep;
    const unsigned ldsw = (unsigned)wid * 1024u;
    const int aoff = lds_byte(wr * 64 + fr, fq * 8), boff = lds_byte(wc * 32 + fr, fq * 8);
#define PG8_SA(b, h) (((b) * 2 + (h)) * HTB)
#define PG8_SB(b, h) ((4 + (b) * 2 + (h)) * HTB)
#define PG8_STAGE(bufoff, gbase, voff) do { _Pragma("unroll") for (int _i = 0; _i < 2; ++_i) \
        __builtin_amdgcn_global_load_lds((const unsigned*)((const char*)(gbase) + (voff)[_i]), (PG8_LAS unsigned*)(lds + (bufoff) + ldsw + _i * 8192), 16, 0, 0); } while (0)
#define PG8_LDA(dst, b, h) do { _Pragma("unroll") for (int m = 0; m < 4; ++m) _Pragma("unroll") for (int k = 0; k < 2; ++k) dst[m][k] = *(const PG8_LAS bf16x8*)(lds + PG8_SA(b, h) + aoff + m * 2048 + k * 1024); } while (0)
#define PG8_LDB(dst, b, h) do { _Pragma("unroll") for (int n = 0; n < 2; ++n) _Pragma("unroll") for (int k = 0; k < 2; ++k) dst[n][k] = *(const PG8_LAS bf16x8*)(lds + PG8_SB(b, h) + boff + n * 2048 + k * 1024); } while (0)
#define PG8_MMA(ai, bj, At, Bt) do { __builtin_amdgcn_s_setprio(1); _Pragma("unroll") for (int m = 0; m < 4; ++m) _Pragma("unroll") for (int n = 0; n < 2; ++n) _Pragma("unroll") for (int k = 0; k < 2; ++k) \
        acc[ai][bj][m][n] = __builtin_amdgcn_mfma_f32_16x16x32_bf16(Bt[n][k], At[m][k], acc[ai][bj][m][n], 0, 0, 0); __builtin_amdgcn_s_setprio(0); } while (0)
#define PG8_WAIT_V(n) asm volatile("s_waitcnt vmcnt(" #n ")" ::: "memory")
#define PG8_WAIT_L(n) asm volatile("s_waitcnt lgkmcnt(" #n ")" ::: "memory")
#define PG8_BAR __builtin_amdgcn_s_barrier()
#define PG8_SCHED __builtin_amdgcn_sched_barrier(0)
    Unit cur, nxt; int ui = 0;
    if (!S.next(0, cur)) return;
    f32x4 acc[2][2][4][2];
#pragma unroll
    for (int a = 0; a < 2; ++a)
#pragma unroll
        for (int b = 0; b < 2; ++b)
#pragma unroll
            for (int m = 0; m < 4; ++m)
#pragma unroll
                for (int n = 0; n < 2; ++n) acc[a][b][m][n] = (f32x4){0.f, 0.f, 0.f, 0.f};
    bf16x8 At[4][2], B0[2][2], B1[2][2];
    const char* cA = (const char*)g.A + (size_t)cur.pm * tstep; const char* cB = (const char*)g.Bt + (size_t)cur.pn * tstep;
    S.a_ready(cur);
    if constexpr (SP2) {
        PG8_STAGE(PG8_SB(0, 0), cB, voffB); PG8_STAGE(PG8_SB(0, 1), cB + hstep, voffB); PG8_STAGE(PG8_SA(0, 0), cA, voffA); PG8_STAGE(PG8_SA(0, 1), cA + hstep, voffA);
        if (wr == 1) PG8_BAR;
        PG8_WAIT_V(2); PG8_BAR;
        PG8_STAGE(PG8_SB(1, 0), cB + kstep, voffB); PG8_STAGE(PG8_SA(1, 0), cA + kstep, voffA); PG8_STAGE(PG8_SB(1, 1), cB + hstep + kstep, voffB);
        PG8_WAIT_V(6); PG8_BAR;
    } else {
        PG8_STAGE(PG8_SB(0, 0), cB, voffB); PG8_STAGE(PG8_SA(0, 0), cA, voffA); PG8_STAGE(PG8_SB(0, 1), cB + hstep, voffB); PG8_STAGE(PG8_SA(0, 1), cA + hstep, voffA);
        if (wr == 1) PG8_BAR;
        PG8_WAIT_V(4); PG8_BAR;
        PG8_STAGE(PG8_SB(1, 0), cB + kstep, voffB); PG8_STAGE(PG8_SA(1, 0), cA + kstep, voffA); PG8_STAGE(PG8_SB(1, 1), cB + hstep + kstep, voffB);
        PG8_WAIT_V(6); PG8_BAR;
    }
    for (;;) {
        const bool has_next = S.next(ui + 1, nxt);
        const char* nA = has_next ? (const char*)g.A + (size_t)nxt.pm * tstep : cA; const char* nB = has_next ? (const char*)g.Bt + (size_t)nxt.pn * tstep : cB;
        for (int t = 0; t < nt; t += 2) {
            const bool last = (t == nt - 2);
            const char* a1 = cA + (size_t)(t + 1) * kstep;
            const char* a2 = last ? nA : cA + (size_t)(t + 2) * kstep; const char* b2 = last ? nB : cB + (size_t)(t + 2) * kstep;
            const char* a3 = a2 + kstep; const char* b3 = b2 + kstep;
            if (last && has_next) S.a_ready(nxt);
            if constexpr (SP2) {
            PG8_LDB(B0, 0, 0); PG8_LDB(B1, 0, 1); PG8_SCHED; PG8_LDA(At, 0, 0); PG8_STAGE(PG8_SA(1, 1), a1 + hstep, voffA);
            PG8_WAIT_V(8); PG8_WAIT_L(0); PG8_BAR; PG8_MMA(0, 0, At, B0); PG8_MMA(0, 1, At, B1); PG8_BAR; PG8_SCHED;
            PG8_LDA(At, 0, 1); PG8_STAGE(PG8_SB(0, 0), b2, voffB); PG8_STAGE(PG8_SB(0, 1), b2 + hstep, voffB); PG8_STAGE(PG8_SA(0, 0), a2, voffA);
            PG8_WAIT_V(8); PG8_WAIT_L(0); PG8_BAR; PG8_MMA(1, 0, At, B0); PG8_MMA(1, 1, At, B1); PG8_BAR; PG8_SCHED;
            PG8_LDB(B0, 1, 0); PG8_LDB(B1, 1, 1); PG8_SCHED; PG8_LDA(At, 1, 0); PG8_STAGE(PG8_SA(0, 1), a2 + hstep, voffA);
            PG8_WAIT_V(8); PG8_WAIT_L(0); PG8_BAR; PG8_MMA(0, 0, At, B0); PG8_MMA(0, 1, At, B1); PG8_BAR; PG8_SCHED;
            PG8_LDA(At, 1, 1); PG8_STAGE(PG8_SB(1, 0), b3, voffB); PG8_STAGE(PG8_SB(1, 1), b3 + hstep, voffB); PG8_STAGE(PG8_SA(1, 0), a3, voffA);
            PG8_WAIT_V(8); PG8_WAIT_L(0); PG8_BAR; PG8_MMA(1, 0, At, B0); PG8_MMA(1, 1, At, B1); PG8_BAR; PG8_SCHED;
            } else {
            PG8_LDB(B0, 0, 0); PG8_SCHED; PG8_LDA(At, 0, 0); PG8_STAGE(PG8_SA(1, 1), a1 + hstep, voffA);
            PG8_WAIT_L(8); PG8_BAR; PG8_WAIT_L(0); PG8_MMA(0, 0, At, B0); PG8_BAR; PG8_SCHED;
            PG8_LDB(B1, 0, 1); PG8_STAGE(PG8_SB(0, 0), b2, voffB);
            PG8_BAR; PG8_WAIT_L(0); PG8_MMA(0, 1, At, B1); PG8_BAR;
            PG8_LDA(At, 0, 1); PG8_STAGE(PG8_SA(0, 0), a2, voffA);
            PG8_BAR; PG8_WAIT_L(0); PG8_MMA(1, 0, At, B0); PG8_BAR; PG8_SCHED;
            PG8_STAGE(PG8_SB(0, 1), b2 + hstep, voffB);
            PG8_WAIT_V(6); PG8_BAR; PG8_MMA(1, 1, At, B1); PG8_BAR;
            PG8_LDB(B0, 1, 0); PG8_SCHED; PG8_LDA(At, 1, 0); PG8_STAGE(PG8_SA(0, 1), a2 + hstep, voffA);
            PG8_WAIT_L(8); PG8_BAR; PG8_WAIT_L(0); PG8_MMA(0, 0, At, B0); PG8_BAR; PG8_SCHED;
            PG8_LDB(B1, 1, 1); PG8_STAGE(PG8_SB(1, 0), b3, voffB);
            PG8_BAR; PG8_WAIT_L(0); PG8_MMA(0, 1, At, B1); PG8_BAR;
            PG8_LDA(At, 1, 1); PG8_STAGE(PG8_SA(1, 0), a3, voffA);
            PG8_BAR; PG8_WAIT_L(0); PG8_MMA(1, 0, At, B0); PG8_BAR; PG8_SCHED;
            PG8_STAGE(PG8_SB(1, 1), b3 + hstep, voffB);
            PG8_WAIT_V(6); PG8_BAR; PG8_MMA(1, 1, At, B1); PG8_BAR;
            }
        }
        if constexpr (ALIGN_EPI) { if (wr == 0) PG8_BAR; }
        if constexpr (!Epi::AFTER_DRAIN) { E(acc, cur, wr, wc, fr, fq); S.done(cur); }
        if (!has_next) break;
#pragma unroll
        for (int a = 0; a < 2; ++a)
#pragma unroll
            for (int b = 0; b < 2; ++b)
#pragma unroll
                for (int m = 0; m < 4; ++m)
#pragma unroll
                    for (int n = 0; n < 2; ++n) acc[a][b][m][n] = (f32x4){0.f, 0.f, 0.f, 0.f};
        cur = nxt; cA = nA; cB = nB; ++ui;
        if constexpr (ALIGN_EPI) { if (wr == 1) PG8_BAR; }
    }
    PG8_WAIT_V(0);
    if constexpr (!ALIGN_EPI) { if (wr == 0) PG8_BAR; }
    PG8_BAR;
    if constexpr (Epi::AFTER_DRAIN) { E.fused(acc, cur, wr, wc, fr, fq, lds, wid, lane); S.done(cur); }
#undef PG8_SA
#undef PG8_SB
#undef PG8_STAGE
#undef PG8_LDA
#undef PG8_LDB
#undef PG8_MMA
#undef PG8_WAIT_V
#undef PG8_WAIT_L
#undef PG8_BAR
#undef PG8_SCHED
}
}

namespace pg8 {
typedef float f32x2 __attribute__((ext_vector_type(2)));
typedef __bf16 bf16x2_t __attribute__((ext_vector_type(2)));
typedef unsigned u32x2v __attribute__((ext_vector_type(2)));
constexpr int MROWS = 16384, DM = 1024, DFF = 2816, DFF2 = 5632;
constexpr float RMS_EPS = 1e-6f;
__device__ __forceinline__ unsigned pkbf(float lo, float hi) { f32x2 v = {lo, hi}; bf16x2_t b = __builtin_convertvector(v, bf16x2_t); return __builtin_bit_cast(unsigned, b); }
__device__ __forceinline__ u32x4 pk8(f32x4 a, f32x4 b) { u32x4 w; w.x = pkbf(a[0], a[1]); w.y = pkbf(a[2], a[3]); w.z = pkbf(b[0], b[1]); w.w = pkbf(b[2], b[3]); return w; }
typedef unsigned long long rss_t;
constexpr float RSS_SCALE = 1048576.0f;
__device__ __forceinline__ rss_t rss_of(float sq) { return (rss_t)(sq * RSS_SCALE + 0.5f); }
__device__ __forceinline__ void rss_add(rss_t* p, float sq) { (void)__hip_atomic_fetch_add(p, rss_of(sq), __ATOMIC_RELAXED, __HIP_MEMORY_SCOPE_AGENT); }
__device__ __forceinline__ float rstd_of(rss_t ss) { return rsqrtf((float)ss * (1.0f / (1024.0f * RSS_SCALE)) + RMS_EPS); }
__device__ __forceinline__ float sigmoidf_fast(float g) { return __builtin_amdgcn_rcpf(1.0f + __expf(-g)); }
__device__ __forceinline__ float gelu_tanh(float x) { const float u = x * (1.5957691216057308f + 0.07135481627159f * x * x); return x * sigmoidf_fast(u); }
__device__ __forceinline__ f32x4 gelu4(f32x4 v) { f32x4 o; o[0] = gelu_tanh(v[0]); o[1] = gelu_tanh(v[1]); o[2] = gelu_tanh(v[2]); o[3] = gelu_tanh(v[3]); return o; }
__device__ __forceinline__ float sumsq4(f32x4 v) { return (v[0] * v[0] + v[1] * v[1]) + (v[2] * v[2] + v[3] * v[3]); }
#define PG8_DPP_FN(name, ctl) __device__ __forceinline__ float name(float x) { float r; asm("s_nop 1\n\tv_mov_b32_dpp %0, %1 " ctl " row_mask:0xf bank_mask:0xf bound_ctrl:1" : "=v"(r) : "v"(x)); return r; }
PG8_DPP_FN(dpp_shr1, "row_shr:1") PG8_DPP_FN(dpp_shr2, "row_shr:2") PG8_DPP_FN(dpp_shl15, "row_shl:15") PG8_DPP_FN(dpp_shl14, "row_shl:14")
__device__ __forceinline__ void taps4(f32x4& y, const f32x4 cur, const f32x4 pv, const f32x4 w1, const f32x4 w0) {
  asm("s_nop 1\n\t"
      "v_fmac_f32_dpp %0, %4, %12 row_shr:1 row_mask:0xf bank_mask:0xf bound_ctrl:1\n\t"
      "v_fmac_f32_dpp %1, %5, %13 row_shr:1 row_mask:0xf bank_mask:0xf bound_ctrl:1\n\t"
      "v_fmac_f32_dpp %2, %6, %14 row_shr:1 row_mask:0xf bank_mask:0xf bound_ctrl:1\n\t"
      "v_fmac_f32_dpp %3, %7, %15 row_shr:1 row_mask:0xf bank_mask:0xf bound_ctrl:1\n\t"
      "v_fmac_f32_dpp %0, %8, %12 row_shl:15 row_mask:0xf bank_mask:0xf bound_ctrl:1\n\t"
      "v_fmac_f32_dpp %1, %9, %13 row_shl:15 row_mask:0xf bank_mask:0xf bound_ctrl:1\n\t"
      "v_fmac_f32_dpp %2, %10, %14 row_shl:15 row_mask:0xf bank_mask:0xf bound_ctrl:1\n\t"
      "v_fmac_f32_dpp %3, %11, %15 row_shl:15 row_mask:0xf bank_mask:0xf bound_ctrl:1\n\t"
      "v_fmac_f32_dpp %0, %4, %16 row_shr:2 row_mask:0xf bank_mask:0xf bound_ctrl:1\n\t"
      "v_fmac_f32_dpp %1, %5, %17 row_shr:2 row_mask:0xf bank_mask:0xf bound_ctrl:1\n\t"
      "v_fmac_f32_dpp %2, %6, %18 row_shr:2 row_mask:0xf bank_mask:0xf bound_ctrl:1\n\t"
      "v_fmac_f32_dpp %3, %7, %19 row_shr:2 row_mask:0xf bank_mask:0xf bound_ctrl:1\n\t"
      "v_fmac_f32_dpp %0, %8, %16 row_shl:14 row_mask:0xf bank_mask:0xf bound_ctrl:1\n\t"
      "v_fmac_f32_dpp %1, %9, %17 row_shl:14 row_mask:0xf bank_mask:0xf bound_ctrl:1\n\t"
      "v_fmac_f32_dpp %2, %10, %18 row_shl:14 row_mask:0xf bank_mask:0xf bound_ctrl:1\n\t"
      "v_fmac_f32_dpp %3, %11, %19 row_shl:14 row_mask:0xf bank_mask:0xf bound_ctrl:1"
      : "+v"(y[0]), "+v"(y[1]), "+v"(y[2]), "+v"(y[3])
      : "v"(cur[0]), "v"(cur[1]), "v"(cur[2]), "v"(cur[3]), "v"(pv[0]), "v"(pv[1]), "v"(pv[2]), "v"(pv[3]),
        "v"(w1[0]), "v"(w1[1]), "v"(w1[2]), "v"(w1[3]), "v"(w0[0]), "v"(w0[1]), "v"(w0[2]), "v"(w0[3]));
}

struct EpiIn {
    static constexpr bool PERM = true, AFTER_DRAIN = false;
    int mode; void* out; const rss_t* rowss; rss_t* rowss_v; float qscale;
    __device__ __forceinline__ void operator()(f32x4 (&acc)[2][2][4][2], const Unit& u, int wr, int wc, int fr, int fq) const {
        asm volatile("" : "+v"(fr), "+v"(fq));
        const int row0 = u.pm * BM + wr * 64 + fr;
        if (mode == 0) {
            int colt = u.pn * BM; const int t = colt >> 10; colt &= 1023;
            bf16_t* base = (bf16_t*)out + (size_t)t * ((size_t)MROWS * DM); const float sc = (t == 0) ? qscale : 1.f;
            const int col0 = colt + wc * 32 + 8 * fq;
#pragma unroll
            for (int ai = 0; ai < 2; ++ai)
#pragma unroll
                for (int m = 0; m < 4; ++m) { const int r = row0 + ai * HALF + m * 16; const float rs = rstd_of(rowss[r]) * sc; bf16_t* rowp = base + (size_t)r * DM + col0;
#pragma unroll
                    for (int bj = 0; bj < 2; ++bj) *(u32x4*)(rowp + bj * HALF) = pk8(acc[ai][bj][m][0] * rs, acc[ai][bj][m][1] * rs);
                    asm volatile("" ::: "memory"); }
        } else if (mode == 1) {
            const int col0 = u.pn * BM + wc * 32 + 8 * fq; const bool vpart = u.pn >= 4;
#pragma unroll
            for (int ai = 0; ai < 2; ++ai)
#pragma unroll
                for (int m = 0; m < 4; ++m) { const int r = row0 + ai * HALF + m * 16; const float rs = rstd_of(rowss[r]); bf16_t* rowp = (bf16_t*)out + (size_t)r * 2048 + col0; float sq = 0.f;
#pragma unroll
                    for (int bj = 0; bj < 2; ++bj) { const f32x4 v0 = gelu4(acc[ai][bj][m][0] * rs), v1 = gelu4(acc[ai][bj][m][1] * rs); sq += sumsq4(v0) + sumsq4(v1); *(u32x4*)(rowp + bj * HALF) = pk8(v0, v1); }
                    if (vpart) { sq += __shfl_xor(sq, 16); sq += __shfl_xor(sq, 32); if (fq == 0) rss_add(rowss_v + r, sq); }
                    asm volatile("" ::: "memory"); }
        } else {
            const int col0 = u.pn * BM + wc * 32 + 8 * fq;
#pragma unroll
            for (int ai = 0; ai < 2; ++ai)
#pragma unroll
                for (int m = 0; m < 4; ++m) { const int r = row0 + ai * HALF + m * 16; const float rs = rstd_of(rowss[r]); bf16_t* rowp = (bf16_t*)out + (size_t)r * DM + col0;
#pragma unroll
                    for (int bj = 0; bj < 2; ++bj) *(u32x4*)(rowp + bj * HALF) = pk8(acc[ai][bj][m][0] * rs, acc[ai][bj][m][1] * rs);
                    asm volatile("" ::: "memory"); }
        }
    }
};
struct EpiResid {
    static constexpr bool PERM = true, AFTER_DRAIN = false;
    const float* base32; bf16_t* XM; float* Xout; rss_t* rowss_next; bool GLU; bool last;
    __device__ __forceinline__ void load_base(size_t off, f32x4& b0, f32x4& b1) const {
        if (base32) { b0 = *(const f32x4*)(base32 + off); b1 = *(const f32x4*)(base32 + off + 4); }
        else { const u32x4 w = *(const u32x4*)(XM + off);
            b0 = (f32x4){__builtin_bit_cast(float, w.x << 16), __builtin_bit_cast(float, w.x & 0xffff0000u), __builtin_bit_cast(float, w.y << 16), __builtin_bit_cast(float, w.y & 0xffff0000u)};
            b1 = (f32x4){__builtin_bit_cast(float, w.z << 16), __builtin_bit_cast(float, w.z & 0xffff0000u), __builtin_bit_cast(float, w.w << 16), __builtin_bit_cast(float, w.w & 0xffff0000u)}; }
    }
    __device__ __forceinline__ void operator()(f32x4 (&acc)[2][2][4][2], const Unit& u, int wr, int wc, int fr, int fq) const {
        asm volatile("" : "+v"(fr), "+v"(fq));
        const int row0 = u.pm * BM + wr * 64 + fr;
        if (!GLU) {
            const int col0 = u.pn * BM + wc * 32 + 8 * fq;
#pragma unroll
            for (int ai = 0; ai < 2; ++ai)
#pragma unroll
                for (int m = 0; m < 4; ++m) { const int r = row0 + ai * HALF + m * 16; float sq = 0.f;
#pragma unroll
                    for (int bj = 0; bj < 2; ++bj) { const size_t off = (size_t)r * DM + col0 + bj * HALF; f32x4 b0, b1; load_base(off, b0, b1);
                        const f32x4 x0 = b0 + acc[ai][bj][m][0], x1 = b1 + acc[ai][bj][m][1];
                        if (last) { *(f32x4*)(Xout + off) = x0; *(f32x4*)(Xout + off + 4) = x1; }
                        else { *(u32x4*)(XM + off) = pk8(x0, x1); sq += sumsq4(x0) + sumsq4(x1); } }
                    if (!last) { sq += __shfl_xor(sq, 16); sq += __shfl_xor(sq, 32); if (fq == 0) rss_add(rowss_next + r, sq); }
                    if (m == 3) asm volatile("" ::: "memory"); }
        } else {
            const int col0 = u.pn * HALF + wc * 32 + 8 * fq;
#pragma unroll
            for (int ai = 0; ai < 2; ++ai)
#pragma unroll
                for (int m = 0; m < 4; ++m) { const int r = row0 + ai * HALF + m * 16; float sq = 0.f; const size_t off = (size_t)r * DM + col0; f32x4 xv[2]; load_base(off, xv[0], xv[1]);
#pragma unroll
                    for (int n = 0; n < 2; ++n) { const f32x4 a = acc[ai][0][m][n], g = acc[ai][1][m][n]; f32x4 v;
#pragma unroll
                        for (int e = 0; e < 4; ++e) v[e] = a[e] * sigmoidf_fast(g[e]);
                        xv[n] = xv[n] + v; sq += sumsq4(xv[n]); }
                    *(u32x4*)(XM + off) = pk8(xv[0], xv[1]);
                    sq += __shfl_xor(sq, 16); sq += __shfl_xor(sq, 32); if (fq == 0) rss_add(rowss_next + r, sq);
                    if (m == 3) asm volatile("" ::: "memory"); }
        }
    }
};
struct EpiUp {
    static constexpr bool PERM = true, AFTER_DRAIN = false;
    bf16_t* ACT; float* EDGE; const rss_t* rowss; const float* cw; const float* cb; PG8_LAS unsigned char* ex;
    __device__ __forceinline__ void operator()(f32x4 (&acc)[2][2][4][2], const Unit& u, int wr, int wc, int fr, int fq) const {
        asm volatile("" : "+v"(fr), "+v"(fq));
        const int row0 = u.pm * BM + wr * 64 + fr;
#pragma unroll
        for (int ai = 0; ai < 2; ++ai)
#pragma unroll
            for (int m = 0; m < 4; ++m) { const float rs = rstd_of(rowss[row0 + ai * HALF + m * 16]);
#pragma unroll
                for (int bj = 0; bj < 2; ++bj)
#pragma unroll
                    for (int n = 0; n < 2; ++n) acc[ai][bj][m][n] = acc[ai][bj][m][n] * rs; }
        PG8_LAS f32x4* EX = (PG8_LAS f32x4*)ex;
        const int slot = ((fr - 14) & 1) * 4 + fq;
        const int ocol = u.pn * HALF + wc * 32 + 8 * fq;
        if (fr >= 14) {
#pragma unroll
            for (int ai = 0; ai < 2; ++ai)
#pragma unroll
                for (int bj = 0; bj < 2; ++bj)
#pragma unroll
                    for (int n = 0; n < 2; ++n) EX[(((((2 * ai + wr) * 4 + wc) * 2 + bj) * 2 + n) * 8) + slot] = acc[ai][bj][3][n];
            if (wr == 1) {
#pragma unroll
                for (int bj = 0; bj < 2; ++bj)
#pragma unroll
                    for (int n = 0; n < 2; ++n) *(f32x4*)(EDGE + (size_t)(u.pm * 4 + 2 + (fr - 14)) * DFF2 + bj * DFF + ocol + 4 * n) = acc[1][bj][3][n];
            }
        }
        if (wr == 0 && fr < 2) {
#pragma unroll
            for (int bj = 0; bj < 2; ++bj)
#pragma unroll
                for (int n = 0; n < 2; ++n) *(f32x4*)(EDGE + (size_t)(u.pm * 4 + fr) * DFF2 + bj * DFF + ocol + 4 * n) = acc[0][bj][0][n];
        }
        asm volatile("s_waitcnt lgkmcnt(0)" ::: "memory"); __builtin_amdgcn_s_barrier(); asm volatile("" ::: "memory");
        const bool bstart = (u.pm & 7) == 0;
#pragma unroll
        for (int n = 0; n < 2; ++n) {
            f32x4 w0[2], w1[2], w2[2], bb[2];
#pragma unroll
            for (int bj = 0; bj < 2; ++bj) { const int oc = bj * DFF + ocol + 4 * n;
                w0[bj] = *(const f32x4*)(cw + oc); w1[bj] = *(const f32x4*)(cw + DFF2 + oc); w2[bj] = *(const f32x4*)(cw + 2 * DFF2 + oc); bb[bj] = *(const f32x4*)(cb + oc); }
#pragma unroll
            for (int ai = 0; ai < 2; ++ai) {
                const int pblk = 2 * ai + wr - 1;
                f32x4 prev[2];
#pragma unroll
                for (int bj = 0; bj < 2; ++bj) prev[bj] = (pblk >= 0) ? EX[((((pblk * 4 + wc) * 2 + bj) * 2 + n) * 8) + slot] : (f32x4){0.f, 0.f, 0.f, 0.f};
#pragma unroll
                for (int m = 0; m < 4; ++m) {
                    f32x4 y[2];
#pragma unroll
                    for (int bj = 0; bj < 2; ++bj) { const f32x4 cur = acc[ai][bj][m][n]; const f32x4 pv = (m == 0) ? prev[bj] : acc[ai][bj][m > 0 ? m - 1 : 0][n];
                        y[bj] = w2[bj] * cur + bb[bj]; taps4(y[bj], cur, pv, w1[bj], w0[bj]); }
                    f32x4 o;
#pragma unroll
                    for (int e = 0; e < 4; ++e) { const float g = y[1][e]; o[e] = g * sigmoidf_fast(g) * y[0][e]; }
                    const bool skip = (ai == 0) && (m == 0) && (wr == 0) && (fr < 2) && !bstart;
                    if (!skip) { u32x2v w; w.x = pkbf(o[0], o[1]); w.y = pkbf(o[2], o[3]); *(u32x2v*)(ACT + (size_t)(row0 + ai * HALF + m * 16) * DFF + ocol + 4 * n) = w; }
                }
                asm volatile("" ::: "memory");
            }
        }
    }
};
}

#define LAS __attribute__((address_space(3)))
typedef unsigned short bf16;
typedef unsigned v4u __attribute__((ext_vector_type(4)));
typedef unsigned v2u __attribute__((ext_vector_type(2)));
typedef float f32x4 __attribute__((ext_vector_type(4)));
typedef float f32x16 __attribute__((ext_vector_type(16)));
typedef short bf16x8 __attribute__((ext_vector_type(8)));
typedef short s16x4 __attribute__((ext_vector_type(4)));
typedef short v4i16_t __attribute__((ext_vector_type(4)));
#define MFMA32(a, b, c) __builtin_amdgcn_mfma_f32_32x32x16_bf16((a), (b), (c), 0, 0, 0)
#define MFMA16(a, b, c) __builtin_amdgcn_mfma_f32_16x16x32_bf16((a), (b), (c), 0, 0, 0)
constexpr int NWAVES = 8;
constexpr int M = 16384, D = 1024, SEQ = 2048, FF = 2816, FF2 = 5632;
constexpr size_t MiB = 1u << 20;
constexpr size_t WS_RS = 0;
constexpr size_t WS_WQKV = 2 * MiB, WS_WO = 14 * MiB, WS_SGIN = 18 * MiB, WS_SGO = 22 * MiB, WS_SSMIN = 24 * MiB, WS_GLU = 26 * MiB, WS_UP = 30 * MiB, WS_DOWN = 74 * MiB;
constexpr size_t WS_XM = 96 * MiB, WS_EDGE = 128 * MiB, WS_BIG = 134 * MiB, WS_END = 262 * MiB;
constexpr int RING_BYTES = 131072, EX_OFF = RING_BYTES, MISC_OFF = EX_OFF + 8192, LDS_BYTES = 147456, SSM_WAVE_LDS = 18432;
constexpr size_t WS_BAR = MiB + MiB / 2, BAR_BYTES = 16384;
constexpr float QSCALE = 0.125f * 1.4426950408889634f;

__device__ __forceinline__ float wave_sum(float v) {
#pragma unroll
    for (int o = 1; o < 64; o <<= 1) v += __shfl_xor(v, o);
    return v;
}
__device__ __forceinline__ unsigned pk2(float lo, float hi) { return pg8::pkbf(lo, hi); }
__device__ __forceinline__ bf16x8 pack8(const float* v) { v4u w; w.x = pk2(v[0], v[1]); w.y = pk2(v[2], v[3]); w.z = pk2(v[4], v[5]); w.w = pk2(v[6], v[7]); return __builtin_bit_cast(bf16x8, w); }
__device__ __forceinline__ float bf_lo(unsigned w) { return __builtin_bit_cast(float, w << 16); }
__device__ __forceinline__ float bf_hi(unsigned w) { return __builtin_bit_cast(float, w & 0xffff0000u); }
__device__ __forceinline__ s16x4 vtr(LAS const unsigned char* p) { return __builtin_bit_cast(s16x4, __builtin_amdgcn_ds_read_tr16_b64_v4i16((LAS v4i16_t*)p)); }
__device__ __forceinline__ int crow(int i, int h) { return (i & 3) + 8 * (i >> 2) + 4 * h; }

__device__ __forceinline__ void transpose_item(const float* W, const float* gk, int K, int N, bf16* WT, int half, LAS float* scr, int item, int lane) {
    const int nblk = N / 32, kb = item / nblk, nb = item % nblk, k0 = 64 * kb, n0 = 32 * nb;
    int d0 = n0; if (half > 0) { const int cc = n0 % half; d0 = 256 * (cc / 128) + 128 * (n0 / half) + (cc % 128); }
    float wv[32];
#pragma unroll
    for (int i = 0; i < 32; ++i) wv[i] = W[(size_t)(k0 + 2 * i + (lane >> 5)) * N + n0 + (lane & 31)];
    if (gk) {
#pragma unroll
        for (int i = 0; i < 32; ++i) wv[i] *= gk[k0 + 2 * i + (lane >> 5)];
    }
#pragma unroll
    for (int i = 0; i < 32; ++i) scr[(2 * i + (lane >> 5)) * 33 + (lane & 31)] = wv[i];
    asm volatile("s_waitcnt lgkmcnt(0)" ::: "memory");
    const int c = lane & 7;
#pragma unroll
    for (int j = 0; j < 4; ++j) { const int n = (lane >> 3) + 8 * j; const LAS float* s = scr + (8 * c) * 33 + n;
        v4u o; o.x = pk2(s[0 * 33], s[1 * 33]); o.y = pk2(s[2 * 33], s[3 * 33]); o.z = pk2(s[4 * 33], s[5 * 33]); o.w = pk2(s[6 * 33], s[7 * 33]);
        *(v4u*)(WT + (size_t)(d0 + n) * K + k0 + 8 * c) = o; }
    asm volatile("s_waitcnt lgkmcnt(0)" ::: "memory");
}
__device__ __forceinline__ void convert_matrix(const float* W, const float* gk, int K, int N, bf16* WT, int half, LAS float* scr, int gw, int ngw, int lane) {
    asm volatile("" : "+v"(lane));
    const int items = (K / 64) * (N / 32);
    for (int it = gw; it < items; it += ngw) transpose_item(W, gk, K, N, WT, half, scr, it, lane);
}

__device__ __forceinline__ void convert4(const float* W0, const float* g0, int K0, int N0, bf16* T0, int h0, const float* W1, int K1, int N1, bf16* T1, int h1,
                                         const float* W2, const float* g2, int K2, int N2, bf16* T2, int h2, const float* W3, int K3, int N3, bf16* T3, int h3, LAS float* scr, int gw, int ngw, int lane) {
    asm volatile("" : "+v"(lane));
    const int n0 = (K0 / 64) * (N0 / 32), n1 = (K1 / 64) * (N1 / 32), n2 = (K2 / 64) * (N2 / 32), n3 = (K3 / 64) * (N3 / 32);
    for (int it = gw; it < n0 + n1 + n2 + n3; it += ngw) {
        int r = it;
        if (r < n0) { transpose_item(W0, g0, K0, N0, T0, h0, scr, r, lane); continue; } r -= n0;
        if (r < n1) { transpose_item(W1, nullptr, K1, N1, T1, h1, scr, r, lane); continue; } r -= n1;
        if (r < n2) { transpose_item(W2, g2, K2, N2, T2, h2, scr, r, lane); continue; } r -= n2;
        transpose_item(W3, nullptr, K3, N3, T3, h3, scr, r, lane);
    }
}

__device__ __forceinline__ void attn_phase(const bf16* Qb, const bf16* Kb, const bf16* Vb, bf16* Ob, LAS unsigned char* vbuf, int gwave, int ngw, int lane) {
    asm volatile("" : "+v"(lane));
    const int r = lane & 31, h = lane >> 5, i16 = lane & 15, g16 = lane >> 4, tq = i16 >> 2, tp = i16 & 3;
    const int troff = tq * 144 + (16 * (g16 & 1)) * 2 + 8 * tp;
    bf16x8 qn[4], kn[4]; v4u vn[4];
    if (gwave < 8192) { const int qb = gwave & 63, bh = gwave >> 6, hd = bh & 15; const size_t rowbase = (size_t)(bh >> 4) * SEQ;
        const bf16* qp = Qb + (rowbase + qb * 32 + r) * D + hd * 64 + 8 * h; const bf16* kp0 = Kb + (rowbase + qb * 32 + r) * D + hd * 64 + 8 * h;
        const bf16* vp0 = Vb + (rowbase + qb * 32 + (lane >> 3)) * D + hd * 64 + (lane & 7) * 8;
#pragma unroll
        for (int kk = 0; kk < 4; ++kk) { qn[kk] = *(const bf16x8*)(qp + 16 * kk); kn[kk] = *(const bf16x8*)(kp0 + 16 * kk); }
#pragma unroll
        for (int i = 0; i < 4; ++i) vn[i] = *(const v4u*)(vp0 + (size_t)(8 * i) * D); }
    for (int unit = gwave; unit < 8192; unit += ngw) {
        const int qb = unit & 63, bh = unit >> 6, hd = bh & 15; const size_t rowbase = (size_t)(bh >> 4) * SEQ;
        bf16x8 qf[4];
#pragma unroll
        for (int kk = 0; kk < 4; ++kk) qf[kk] = qn[kk];
        bf16x8 k2[4]; v4u v2[4];
        { const int un = (unit + ngw < 8192) ? unit + ngw : unit; const int qb2 = un & 63, bh2 = un >> 6, hd2 = bh2 & 15; const size_t rb2 = (size_t)(bh2 >> 4) * SEQ;
          const bf16* qp = Qb + (rb2 + qb2 * 32 + r) * D + hd2 * 64 + 8 * h; const bf16* kp0 = Kb + (rb2 + qb2 * 32 + r) * D + hd2 * 64 + 8 * h;
          const bf16* vp0 = Vb + (rb2 + qb2 * 32 + (lane >> 3)) * D + hd2 * 64 + (lane & 7) * 8;
#pragma unroll
          for (int kk = 0; kk < 4; ++kk) { qn[kk] = *(const bf16x8*)(qp + 16 * kk); k2[kk] = *(const bf16x8*)(kp0 + 16 * kk); }
#pragma unroll
          for (int i = 0; i < 4; ++i) v2[i] = *(const v4u*)(vp0 + (size_t)(8 * i) * D); }
        f32x16 o0, o1;
#pragma unroll
        for (int i = 0; i < 16; ++i) { o0[i] = 0.f; o1[i] = 0.f; }
        float srow = 0.f;
        const bf16* kbase = Kb + (rowbase + r) * D + hd * 64 + 8 * h;
        const bf16* vbase = Vb + (rowbase + (lane >> 3)) * D + hd * 64 + (lane & 7) * 8;
        for (int kt = qb; kt >= 0; --kt) {
            bf16x8 kf[4];
#pragma unroll
            for (int kk = 0; kk < 4; ++kk) kf[kk] = kn[kk];
#pragma unroll
            for (int i = 0; i < 4; ++i) *(LAS v4u*)(vbuf + ((lane >> 3) + 8 * i) * 144 + (lane & 7) * 16) = vn[i];
            { const int kp = kt > 0 ? kt - 1 : 0;
#pragma unroll
              for (int kk = 0; kk < 4; ++kk) kn[kk] = *(const bf16x8*)(kbase + (size_t)kp * 32 * D + 16 * kk);
#pragma unroll
              for (int i = 0; i < 4; ++i) vn[i] = *(const v4u*)(vbase + ((size_t)kp * 32 + 8 * i) * D); }
            f32x16 x;
#pragma unroll
            for (int i = 0; i < 16; ++i) x[i] = 0.f;
#pragma unroll
            for (int kk = 0; kk < 4; ++kk) x = MFMA32(kf[kk], qf[kk], x);
            const bool diag = (kt == qb);
            float lb[16], l1[16];
#pragma unroll
            for (int i = 0; i < 16; ++i) {
                const float z = x[i];
                const float e = __builtin_amdgcn_exp2f(-fabsf(z));
                const float sp = fmaxf(z, 0.f) + __builtin_amdgcn_logf(1.0f + e);
                float l1m = -sp, lbv = z - sp;
                if (diag) { const bool valid = crow(i, h) < r; l1m = valid ? l1m : 0.f; lbv = valid ? lbv : -INFINITY; }
                l1[i] = l1m; lb[i] = lbv;
            }
            float within[16], gown[4], goth[4];
#pragma unroll
            for (int q = 0; q < 4; ++q) { const float w3 = l1[4 * q + 3], w2 = w3 + l1[4 * q + 2], w1 = w2 + l1[4 * q + 1];
                within[4 * q + 3] = 0.f; within[4 * q + 2] = w3; within[4 * q + 1] = w2; within[4 * q] = w1; gown[q] = w1 + l1[4 * q]; }
#pragma unroll
            for (int q = 0; q < 4; ++q) goth[q] = __shfl_xor(gown[q], 32);
            const float T0 = gown[0] + goth[0], T1 = gown[1] + goth[1], T2 = gown[2] + goth[2], T3 = gown[3] + goth[3];
            float after[4]; after[3] = 0.f; after[2] = T3; after[1] = T3 + T2; after[0] = after[1] + T1;
            float w[16];
#pragma unroll
            for (int q = 0; q < 4; ++q) { const float basec = srow + after[q] + (h == 0 ? goth[q] : 0.f);
#pragma unroll
                for (int e = 0; e < 4; ++e) w[4 * q + e] = __builtin_amdgcn_exp2f(lb[4 * q + e] + basec + within[4 * q + e]); }
            srow += after[0] + T0;
            const bf16x8 pf0 = pack8(w), pf1 = pack8(w + 8);
            asm volatile("s_waitcnt lgkmcnt(0)" ::: "memory");
#pragma unroll
            for (int s = 0; s < 2; ++s) {
                const bf16x8 pf = s ? pf1 : pf0;
#pragma unroll
                for (int db = 0; db < 2; ++db) {
                    const s16x4 lo = vtr(vbuf + (16 * s + 4 * h) * 144 + 64 * db + troff), hi = vtr(vbuf + (16 * s + 8 + 4 * h) * 144 + 64 * db + troff);
                    const bf16x8 a = __builtin_shufflevector(lo, hi, 0, 1, 2, 3, 4, 5, 6, 7);
                    if (db == 0) o0 = MFMA32(a, pf, o0); else o1 = MFMA32(a, pf, o1);
                }
            }
            asm volatile("s_waitcnt lgkmcnt(0)" ::: "memory");
            if (__all(srow < -64.0f)) break;
        }
        bf16* op = Ob + (rowbase + qb * 32 + r) * D + hd * 64 + 4 * h;
#pragma unroll
        for (int g = 0; g < 4; ++g) {
            v2u a; a.x = pk2(o0[4 * g], o0[4 * g + 1]); a.y = pk2(o0[4 * g + 2], o0[4 * g + 3]); *(v2u*)(op + 8 * g) = a;
            v2u b; b.x = pk2(o1[4 * g], o1[4 * g + 1]); b.y = pk2(o1[4 * g + 2], o1[4 * g + 3]); *(v2u*)(op + 32 + 8 * g) = b;
        }
#pragma unroll
        for (int kk = 0; kk < 4; ++kk) kn[kk] = k2[kk];
#pragma unroll
        for (int i = 0; i < 4; ++i) vn[i] = v2[i];
    }
}

__device__ __forceinline__ void sg_phase(const bf16* H, const pg8::rss_t* rowss_v, const float* vg, const float* Ws, const float* bs, bf16* GATED, LAS unsigned char* lds, int G, int bid, int tid) {
    asm volatile("" : "+v"(tid));
    const int wave = tid >> 6, lane = tid & 63, tb = wave & 3, dh = wave >> 2;
    const int r = lane & 31, h = lane >> 5, i16 = lane & 15, g16 = lane >> 4, tq = i16 >> 2, tp = i16 & 3;
    const int troff = tq * 272 + (16 * (g16 & 1)) * 2 + 8 * tp;
    for (int unit = bid; unit < 1024; unit += G) {
        const int g = unit & 7; const size_t rowbase = (size_t)(unit >> 3) * 128;
#pragma unroll
        for (int i = 0; i < 4; ++i) { const int s = (tid >> 4) + 32 * i, ch = tid & 15; const size_t row = rowbase + s;
            const v4u raw = *(const v4u*)(H + row * 2048 + 1024 + g * 128 + ch * 8); const float rs = pg8::rstd_of(rowss_v[row]);
            const f32x4 g0 = *(const f32x4*)(vg + g * 128 + ch * 8), g1 = *(const f32x4*)(vg + g * 128 + ch * 8 + 4);
            v4u o; o.x = pk2(bf_lo(raw.x) * rs * g0[0], bf_hi(raw.x) * rs * g0[1]); o.y = pk2(bf_lo(raw.y) * rs * g0[2], bf_hi(raw.y) * rs * g0[3]);
            o.z = pk2(bf_lo(raw.z) * rs * g1[0], bf_hi(raw.z) * rs * g1[1]); o.w = pk2(bf_lo(raw.w) * rs * g1[2], bf_hi(raw.w) * rs * g1[3]);
            *(LAS v4u*)(lds + s * 272 + ch * 16) = o; }
        const int t = 32 * tb + r;
        f32x4 wq0[8], wq1[8];
        { const float* wrow = Ws + ((size_t)(g * 128 + t) * 128 + 8 * h);
#pragma unroll
          for (int kk = 0; kk < 8; ++kk) { wq0[kk] = *(const f32x4*)(wrow + 16 * kk); wq1[kk] = *(const f32x4*)(wrow + 16 * kk + 4); } }
        __syncthreads();
        f32x16 a0, a1;
#pragma unroll
        for (int i = 0; i < 16; ++i) { a0[i] = 0.f; a1[i] = 0.f; }
#pragma unroll
        for (int kk = 0; kk < 8; ++kk) {
            if (kk <= 2 * tb + 1) {
            const int sb = 16 * kk + 8 * h; const f32x4 w0 = wq0[kk], w1 = wq1[kk]; float wv[8];
#pragma unroll
            for (int j = 0; j < 4; ++j) { wv[j] = (sb + j <= t) ? w0[j] : 0.f; wv[4 + j] = (sb + 4 + j <= t) ? w1[j] : 0.f; }
            const bf16x8 bfr = pack8(wv);
#pragma unroll
            for (int db = 0; db < 2; ++db) { const int dbk = 2 * dh + db;
                const s16x4 lo = vtr(lds + (16 * kk + 8 * h) * 272 + 64 * dbk + troff), hi = vtr(lds + (16 * kk + 8 * h + 4) * 272 + 64 * dbk + troff);
                const bf16x8 a = __builtin_shufflevector(lo, hi, 0, 1, 2, 3, 4, 5, 6, 7);
                if (db == 0) a0 = MFMA32(a, bfr, a0); else a1 = MFMA32(a, bfr, a1); }
            }
        }
        const size_t row = rowbase + t; const float bias = bs[g * 128 + t];
#pragma unroll
        for (int db = 0; db < 2; ++db)
#pragma unroll
            for (int gq = 0; gq < 4; ++gq) { const int d0 = 32 * (2 * dh + db) + 8 * gq + 4 * h;
                const v2u ur = *(const v2u*)(H + row * 2048 + g * 128 + d0);
                const float s0 = (db ? a1[4 * gq] : a0[4 * gq]) + bias, s1 = (db ? a1[4 * gq + 1] : a0[4 * gq + 1]) + bias, s2 = (db ? a1[4 * gq + 2] : a0[4 * gq + 2]) + bias, s3 = (db ? a1[4 * gq + 3] : a0[4 * gq + 3]) + bias;
                v2u o; o.x = pk2(bf_lo(ur.x) * s0, bf_hi(ur.x) * s1); o.y = pk2(bf_lo(ur.y) * s2, bf_hi(ur.y) * s3);
                *(v2u*)(GATED + row * D + g * 128 + d0) = o; }
        __syncthreads();
    }
}

__device__ __forceinline__ void sincos_cw(float x, float& s, float& c) {
    const float k = rintf(x * 0.6366197723675814f);
    float rr = fmaf(-k, 1.5707963705062866f, x); rr = fmaf(-k, -4.371139000186243e-08f, rr);
    const int q = ((int)k) & 3; const float r2 = rr * rr;
    const float sp = rr + rr * r2 * (-1.6666667163e-1f + r2 * (8.3333337680e-3f + r2 * (-1.9841270114e-4f + r2 * 2.7557314297e-6f)));
    const float cp = 1.f + r2 * (-0.5f + r2 * (4.1666667908e-2f + r2 * (-1.3888889225e-3f + r2 * (2.4801587642e-5f + r2 * (-2.7557319224e-7f)))));
    s = (q == 0) ? sp : (q == 1) ? cp : (q == 2) ? -sp : -cp;
    c = (q == 0) ? cp : (q == 1) ? -sp : (q == 2) ? -cp : sp;
}
__device__ __forceinline__ void ssm_phase(const bf16* U, const float* lam_re, const float* lam_im, const float* log_dt, const float* b_re, const float* b_im, const float* c_re, const float* c_im,
                                          const float* d_skip, bf16* Y, LAS unsigned char* ldsw, int item0, int istride, int lane) {
    asm volatile("" : "+v"(lane));
    const int r = lane & 31, hh = lane >> 5, hc = lane & 15, fq = lane >> 4;
    const int i16 = lane & 15, tq = i16 >> 2, tp = i16 & 3;
    for (int item = item0; item < 512; item += istride) {
        const int b = item >> 6, g = item & 63;
        const float lr = fminf(lam_re[g * 64 + lane], -1e-4f), li = lam_im[g * 64 + lane], dt = expf(log_dt[g]), mag = expf(dt * lr);
        float sn, cs; sincos_cw(dt * li, sn, cs);
        const float ar = mag * cs, ai = mag * sn, den = lr * lr + li * li;
        const float cre = ((ar - 1.0f) * lr + ai * li) / den, cim = (ai * lr - (ar - 1.0f) * li) / den;
        bf16x8 bfre[2], bfim[2];
#pragma unroll
        for (int pb = 0; pb < 2; ++pb) { const int pp = 32 * pb + r; const float cr = __shfl(cre, pp), ci = __shfl(cim, pp);
            const float* brp = b_re + ((size_t)(g * 64 + pp) * 16 + 8 * hh); const float* bip = b_im + ((size_t)(g * 64 + pp) * 16 + 8 * hh);
            const f32x4 br0 = *(const f32x4*)brp, br1 = *(const f32x4*)(brp + 4), bi0 = *(const f32x4*)bip, bi1 = *(const f32x4*)(bip + 4);
            float re[8], im[8];
#pragma unroll
            for (int j = 0; j < 4; ++j) { re[j] = cr * br0[j] - ci * bi0[j]; im[j] = cr * bi0[j] + ci * br0[j]; re[4 + j] = cr * br1[j] - ci * bi1[j]; im[4 + j] = cr * bi1[j] + ci * br1[j]; }
            bfre[pb] = pack8(re); bfim[pb] = pack8(im); }
        bf16x8 cf[4];
#pragma unroll
        for (int kk = 0; kk < 4; ++kk) { const int kx0 = 32 * kk + 8 * fq; const float* src = (kk < 2) ? (c_re + ((size_t)(g * 16 + hc) * 64 + kx0)) : (c_im + ((size_t)(g * 16 + hc) * 64 + kx0 - 64));
            const f32x4 c0 = *(const f32x4*)src, c1 = *(const f32x4*)(src + 4); const float sg = (kk < 2) ? 1.f : -1.f; float cv[8];
#pragma unroll
            for (int j = 0; j < 4; ++j) { cv[j] = sg * c0[j]; cv[4 + j] = sg * c1[j]; }
            cf[kk] = pack8(cv); }
        const f32x4 dsk = *(const f32x4*)(d_skip + g * 16 + 4 * fq);
        float xr = 0.f, xi = 0.f;
        const bf16* ubase = U + ((size_t)b * SEQ) * D + g * 16;
        const bf16* upA = ubase + (size_t)r * D + 8 * hh;
        const bf16* upE = ubase + (size_t)hc * D + 4 * fq;
        bf16x8 nuf = *(const bf16x8*)upA; v2u ne0 = *(const v2u*)upE, ne1 = *(const v2u*)(upE + (size_t)16 * D);
        for (int sub = 0; sub < 64; ++sub) {
            const size_t t0 = (size_t)b * SEQ + sub * 32;
            const bf16x8 uf = nuf; const v2u e0 = ne0, e1 = ne1;
            { const int sn = (sub < 63) ? sub + 1 : 63; const size_t o = (size_t)sn * 32 * D;
              nuf = *(const bf16x8*)(upA + o); ne0 = *(const v2u*)(upE + o); ne1 = *(const v2u*)(upE + o + (size_t)16 * D); }
            f32x16 zero;
#pragma unroll
            for (int i = 0; i < 16; ++i) zero[i] = 0.f;
#pragma unroll
            for (int xb = 0; xb < 4; ++xb) { const f32x16 d = MFMA32(uf, (xb == 0 ? bfre[0] : xb == 1 ? bfre[1] : xb == 2 ? bfim[0] : bfim[1]), zero);
#pragma unroll
                for (int q = 0; q < 4; ++q) *(LAS v4u*)(ldsw + (32 * xb + r) * 144 + (8 * q + 4 * hh) * 4) = __builtin_bit_cast(v4u, (f32x4){d[4 * q], d[4 * q + 1], d[4 * q + 2], d[4 * q + 3]}); }
            asm volatile("s_waitcnt lgkmcnt(0)" ::: "memory");
            f32x4 cbr[2], cbi[2], nbr[2], nbi[2];
            const LAS unsigned char* rre = ldsw + lane * 144; const LAS unsigned char* rim = ldsw + (64 + lane) * 144;
#pragma unroll
            for (int k = 0; k < 2; ++k) { cbr[k] = __builtin_bit_cast(f32x4, *(const LAS v4u*)(rre + 16 * k)); cbi[k] = __builtin_bit_cast(f32x4, *(const LAS v4u*)(rim + 16 * k)); }
#pragma unroll
            for (int bt = 0; bt < 4; ++bt) {
                if (bt < 3) {
#pragma unroll
                    for (int k = 0; k < 2; ++k) { nbr[k] = __builtin_bit_cast(f32x4, *(const LAS v4u*)(rre + 32 * (bt + 1) + 16 * k)); nbi[k] = __builtin_bit_cast(f32x4, *(const LAS v4u*)(rim + 32 * (bt + 1) + 16 * k)); }
                }
                float xrs[8], xis[8];
#pragma unroll
                for (int k = 0; k < 8; ++k) { const float nxr = fmaf(ar, xr, fmaf(-ai, xi, cbr[k >> 2][k & 3])), nxi = fmaf(ar, xi, fmaf(ai, xr, cbi[k >> 2][k & 3])); xr = nxr; xi = nxi; xrs[k] = xr; xis[k] = xi; }
                {
                    v4u wr_, wi_;
                    wr_.x = pk2(xrs[0], xrs[1]); wr_.y = pk2(xrs[2], xrs[3]); wr_.z = pk2(xrs[4], xrs[5]); wr_.w = pk2(xrs[6], xrs[7]);
                    wi_.x = pk2(xis[0], xis[1]); wi_.y = pk2(xis[2], xis[3]); wi_.z = pk2(xis[4], xis[5]); wi_.w = pk2(xis[6], xis[7]);
                    *(LAS v4u*)(ldsw + lane * 144 + 16 * bt) = wr_; *(LAS v4u*)(ldsw + (64 + lane) * 144 + 16 * bt) = wi_;
                }
#pragma unroll
                for (int k = 0; k < 2; ++k) { cbr[k] = nbr[k]; cbi[k] = nbi[k]; }
            }
            asm volatile("s_waitcnt lgkmcnt(0)" ::: "memory");
#pragma unroll
            for (int tb = 0; tb < 2; ++tb) { f32x4 acc = {0.f, 0.f, 0.f, 0.f};
#pragma unroll
                for (int kk = 0; kk < 4; ++kk) { const LAS unsigned char* xp = ldsw + (32 * kk + 8 * fq + tq) * 144 + 32 * tb + 8 * tp;
                    const s16x4 lo = vtr(xp), hi = vtr(xp + 4 * 144); const bf16x8 xf = __builtin_shufflevector(lo, hi, 0, 1, 2, 3, 4, 5, 6, 7); acc = MFMA16(cf[kk], xf, acc); }
                const size_t row = t0 + 16 * tb + hc; const v2u ur = tb ? e1 : e0; const f32x4 u4 = {bf_lo(ur.x), bf_hi(ur.x), bf_lo(ur.y), bf_hi(ur.y)};
                const f32x4 y = pg8::gelu4(acc + dsk * u4);
                v2u o; o.x = pk2(y[0], y[1]); o.y = pk2(y[2], y[3]); *(v2u*)(Y + row * D + g * 16 + 4 * fq) = o; }
            asm volatile("s_waitcnt lgkmcnt(0)" ::: "memory");
        }
    }
}

__device__ __forceinline__ void ffn_fixup(const pg8::StaticOrder& S, const float* EDGE, const float* cw, const float* cb, bf16* ACT, int tid) {
    asm volatile("" : "+v"(tid));
    pg8::Unit u;
    for (int i = 0; S.next(i, u); ++i) {
        const int pm = u.pm; if ((pm & 7) == 0) continue;
        const float* L0 = EDGE + (size_t)((pm - 1) * 4 + 2) * FF2; const float* L1 = L0 + FF2; const float* F0 = EDGE + (size_t)(pm * 4) * FF2; const float* F1 = F0 + FF2;
        for (int idx = tid; idx < 2 * (FF / 4); idx += NWAVES * 64) { const int rr = idx / (FF / 4), c = 4 * (idx - rr * (FF / 4)); f32x4 y[2];
#pragma unroll
            for (int bj = 0; bj < 2; ++bj) { const int oc = bj * FF + c;
                const f32x4 w0 = *(const f32x4*)(cw + oc), w1 = *(const f32x4*)(cw + FF2 + oc), w2 = *(const f32x4*)(cw + 2 * FF2 + oc), bb = *(const f32x4*)(cb + oc);
                const f32x4 l1 = *(const f32x4*)(L1 + oc), f0 = *(const f32x4*)(F0 + oc);
                y[bj] = (rr == 0) ? (w0 * *(const f32x4*)(L0 + oc) + w1 * l1 + w2 * f0 + bb) : (w0 * l1 + w1 * f0 + w2 * *(const f32x4*)(F1 + oc) + bb); }
            v2u o; float ov[4];
#pragma unroll
            for (int e = 0; e < 4; ++e) { const float g = y[1][e]; ov[e] = g * pg8::sigmoidf_fast(g) * y[0][e]; }
            o.x = pk2(ov[0], ov[1]); o.y = pk2(ov[2], ov[3]);
            *(v2u*)(ACT + (size_t)(pm * 256 + rr) * FF + c) = o; }
    }
    asm volatile("s_waitcnt vmcnt(0)" ::: "memory");
    __syncthreads();
}

#define XB_TMO      128
#define XB_XCNT(j)  (256  + 64 * (j))
#define XB_XSUB(j)  (1280 + 64 * (j))
#define XB_XGEN(j)  (2304 + 64 * (j))
#define XB_TOP      3328
#define XB_TOPGEN   3392
#define XCD_BAR_WORDS 3456
#define XB_SPIN_CAP (1u << 18)

__device__ __forceinline__ unsigned xb_ld(unsigned* p)              { return __hip_atomic_load(p, __ATOMIC_RELAXED, __HIP_MEMORY_SCOPE_AGENT); }
__device__ __forceinline__ unsigned xb_add(unsigned* p, unsigned v) { return __hip_atomic_fetch_add(p, v, __ATOMIC_RELAXED, __HIP_MEMORY_SCOPE_AGENT); }
__device__ __forceinline__ unsigned xb_xcc_id() { return (unsigned)__builtin_amdgcn_s_getreg((3 << 11) | 20) & 0xFu; }
#define XB_SPIN(cond, bar) do { unsigned _sp = 0; while (cond) { __builtin_amdgcn_s_sleep(1); \
    if ((++_sp & 255u) == 0u) { if (xb_ld(&(bar)[XB_TMO])) break; if (_sp > XB_SPIN_CAP) { atomicAdd(&(bar)[XB_TMO], 1u); break; } } } } while (0)

struct XcdBarrier {
    unsigned* bar; unsigned x;
    volatile LAS unsigned* st;
};

__device__ __forceinline__ XcdBarrier xcd_barrier_post(unsigned* bar, volatile LAS unsigned* st) {
    XcdBarrier b; b.bar = bar; b.x = xb_xcc_id(); b.st = st;
    if (threadIdx.x == 0) (void)xb_add(&bar[XB_XCNT(b.x)], 1u);
    return b;
}
__device__ __forceinline__ void xcd_barrier_complete(unsigned* bar, unsigned x, unsigned& nloc, unsigned& nx) {
    const unsigned G = gridDim.x * gridDim.y * gridDim.z;
    unsigned sum, cnt, mine, sp = 0u;
    for (;;) {
        sum = 0u; cnt = 0u; mine = 0u;
#pragma unroll
        for (unsigned j = 0; j < 16; ++j) { const unsigned c = xb_ld(&bar[XB_XCNT(j)]); sum += c; cnt += (c > 0u) ? 1u : 0u; mine = (j == x) ? c : mine; }
        if (sum == G) break;
        __builtin_amdgcn_s_sleep(1);
        if ((++sp & 255u) == 0u) { if (xb_ld(&bar[XB_TMO])) break; if (sp > XB_SPIN_CAP) { atomicAdd(&bar[XB_TMO], 1u); break; } }
    }
    nloc = mine > 0u ? mine : 1u; nx = cnt > 0u ? cnt : 1u;
}

__device__ __forceinline__ void xcd_barrier(const XcdBarrier& b) {
    asm volatile("s_waitcnt vmcnt(0)" ::: "memory");
    __syncthreads();
    if (threadIdx.x == 0) {
        unsigned* bar = b.bar;
        __builtin_amdgcn_s_waitcnt(0);
        unsigned nloc = b.st[0], nx = b.st[1];
        if (nloc == 0u) { xcd_barrier_complete(bar, b.x, nloc, nx); b.st[0] = nloc; b.st[1] = nx; }
        const unsigned old = xb_add(&bar[XB_XSUB(b.x)], 1u);
        const unsigned gen = old / nloc;
        if (old + 1u == (gen + 1u) * nloc) {
            __builtin_amdgcn_fence(__ATOMIC_RELEASE, "agent");
            asm volatile("s_waitcnt vmcnt(0)" ::: "memory");
            const unsigned og = xb_add(&bar[XB_TOP], 1u);
            const unsigned tg = og / nx;
            if (og + 1u == (tg + 1u) * nx) xb_add(&bar[XB_TOPGEN], 1u);
            else XB_SPIN(xb_ld(&bar[XB_TOPGEN]) == tg, bar);
            __builtin_amdgcn_fence(__ATOMIC_ACQUIRE, "agent");
            xb_add(&bar[XB_XGEN(b.x)], 1u);
            asm volatile("s_waitcnt vmcnt(0)" ::: "memory");
        } else {
            XB_SPIN(xb_ld(&bar[XB_XGEN(b.x)]) == gen, bar);
            __builtin_amdgcn_fence(__ATOMIC_ACQUIRE, "agent");
            asm volatile("s_waitcnt vmcnt(0)" ::: "memory");
        }
    }
    __syncthreads();
}

#define GRID_SYNC() do { asm volatile("s_waitcnt vmcnt(0)" ::: "memory"); __syncthreads(); \
    if (threadIdx.x == 0) { asm volatile("buffer_wbl2 sc1\n\ts_waitcnt vmcnt(0)" ::: "memory"); } \
    grid.sync(); asm volatile("buffer_inv sc1\n\ts_waitcnt vmcnt(0)" ::: "memory"); } while (0)
struct EpiFinal {
    static constexpr bool PERM = true, AFTER_DRAIN = false;
    const bf16* XM; float* out; const float* gfin; pg8::rss_t* rss; XcdBarrier xb;
    __device__ __forceinline__ void operator()(pg8::f32x4 (&acc)[2][2][4][2], const pg8::Unit& u, int wr, int wc, int fr, int fq) const {
        asm volatile("" : "+v"(fr), "+v"(fq));
        const int row0 = u.pm * pg8::BM + wr * 64 + fr, col0 = u.pn * pg8::BM + wc * 32 + 8 * fq;
#pragma unroll
        for (int ai = 0; ai < 2; ++ai)
#pragma unroll
            for (int m = 0; m < 4; ++m) { const int r = row0 + ai * pg8::HALF + m * 16; float sq = 0.f;
#pragma unroll
                for (int bj = 0; bj < 2; ++bj) { const size_t off = (size_t)r * D + col0 + bj * pg8::HALF; const v4u w = *(const v4u*)(XM + off);
                    acc[ai][bj][m][0] = acc[ai][bj][m][0] + (f32x4){bf_lo(w.x), bf_hi(w.x), bf_lo(w.y), bf_hi(w.y)};
                    acc[ai][bj][m][1] = acc[ai][bj][m][1] + (f32x4){bf_lo(w.z), bf_hi(w.z), bf_lo(w.w), bf_hi(w.w)};
                    sq += pg8::sumsq4(acc[ai][bj][m][0]) + pg8::sumsq4(acc[ai][bj][m][1]); }
                sq += __shfl_xor(sq, 16); sq += __shfl_xor(sq, 32); if (fq == 0) pg8::rss_add(rss + r, sq);
                if (m == 3) asm volatile("" ::: "memory"); }
        xcd_barrier(xb);
        f32x4 gv[2][2];
#pragma unroll
        for (int bj = 0; bj < 2; ++bj)
#pragma unroll
            for (int n = 0; n < 2; ++n) gv[bj][n] = *(const f32x4*)(gfin + col0 + bj * pg8::HALF + 4 * n);
#pragma unroll
        for (int ai = 0; ai < 2; ++ai)
#pragma unroll
            for (int m = 0; m < 4; ++m) { const int r = row0 + ai * pg8::HALF + m * 16; const float rs = pg8::rstd_of(__hip_atomic_load(rss + r, __ATOMIC_RELAXED, __HIP_MEMORY_SCOPE_AGENT));
#pragma unroll
                for (int bj = 0; bj < 2; ++bj) { const size_t off = (size_t)r * D + col0 + bj * pg8::HALF;
                    *(f32x4*)(out + off) = acc[ai][bj][m][0] * rs * gv[bj][0]; *(f32x4*)(out + off + 4) = acc[ai][bj][m][1] * rs * gv[bj][1]; }
                if (m == 3) asm volatile("" ::: "memory"); }
    }
};
struct Args { const float* in[24]; float* out; unsigned char* ws; int never; int pad; };
enum { I_X = 0, I_NORMG, I_FNG, I_WQKV, I_WO, I_SGIN, I_SGNG, I_SGWS, I_SGB, I_SGO, I_SSMIN, I_LRE, I_LIM, I_LDT, I_BRE, I_BIM, I_CRE, I_CIM, I_SSMD, I_GLU, I_UP, I_CONVW, I_CONVB, I_DOWN };

__global__ void __launch_bounds__(NWAVES * 64, 2) trunk_fwd(Args args) {
    extern __shared__ __attribute__((aligned(16))) unsigned char lds_raw[];
    cg::grid_group grid = cg::this_grid();
    LAS unsigned char* lds = (LAS unsigned char*)lds_raw;
    const int tid = threadIdx.x, lane = tid & 63, wave = __builtin_amdgcn_readfirstlane(tid >> 6);
    const int G = gridDim.x, bid0 = blockIdx.x, gw0 = bid0 * NWAVES + wave, ngw = G * NWAVES;
    unsigned char* ws = args.ws;
    if (tid < 32) ((LAS unsigned*)(lds + MISC_OFF))[tid] = 0u;
    __syncthreads();
    const XcdBarrier xbar = xcd_barrier_post((unsigned*)(ws + WS_BAR), (volatile LAS unsigned*)(lds + MISC_OFF));
    pg8::rss_t* RS = (pg8::rss_t*)(ws + WS_RS);
    bf16* WQKV_T = (bf16*)(ws + WS_WQKV); bf16* WO_T = (bf16*)(ws + WS_WO); bf16* SGIN_T = (bf16*)(ws + WS_SGIN); bf16* SGO_T = (bf16*)(ws + WS_SGO);
    bf16* SSMIN_T = (bf16*)(ws + WS_SSMIN); bf16* GLU_T = (bf16*)(ws + WS_GLU); bf16* UP_T = (bf16*)(ws + WS_UP); bf16* DOWN_T = (bf16*)(ws + WS_DOWN);
    float* EDGE = (float*)(ws + WS_EDGE); unsigned char* BIG = ws + WS_BIG;
    float* X = args.out;
    bf16* XM = (bf16*)(ws + WS_XM);
    const float* x_in = args.in[I_X]; const float* norm_g = args.in[I_NORMG];

    {
        for (int i = bid0 * (NWAVES * 64) + tid; i < 9 * M; i += G * NWAVES * 64) RS[M + i] = 0ull;
        LAS float* scr = (LAS float*)(lds + wave * 16384);
        convert4(args.in[I_WQKV], norm_g, D, 3 * D, WQKV_T, 0, args.in[I_WO], D, D, WO_T, 0, args.in[I_UP], norm_g + D, D, FF2, UP_T, FF, args.in[I_DOWN], FF, D, DOWN_T, 0, scr, gw0, ngw, lane);
        for (int m = gw0; m < M; m += ngw) {
            const f32x4* xr = (const f32x4*)(x_in + (size_t)m * D) + lane; float s = 0.f;
            v2u* o = (v2u*)(XM + (size_t)m * D) + lane;
#pragma unroll
            for (int j = 0; j < 4; ++j) { const f32x4 v = xr[64 * j]; s += pg8::sumsq4(v); v2u w; w.x = pk2(v[0], v[1]); w.y = pk2(v[2], v[3]); o[64 * j] = w; }
            s = wave_sum(s); if (lane == 0) RS[m] = pg8::rss_of(s);
        }
    }
    xcd_barrier(xbar);
    if (args.never) grid.sync();

    const bool fused_final = ((M / 256) * (D / 256) == G);
    for (int step = 0; step < 20; ++step) {
        int bid = (int)blockIdx.x; asm volatile("" : "+s"(bid));
        const int layer = step / 5, sub = step - layer * 5, mixer = layer % 3, j = layer / 3;
        const int gw = bid * NWAVES + wave;
        pg8::rss_t* rs_mid = RS + (size_t)(2 * layer + 1) * M;
        if (sub == 0) {
            const pg8::rss_t* rs_in = RS + (size_t)(2 * layer) * M;
            const bf16* Bt = (mixer == 0) ? WQKV_T + (size_t)j * 3 * D * D : (mixer == 1) ? SGIN_T : SSMIN_T; const int N = (mixer == 0) ? 3 * D : (mixer == 1) ? 2 * D : D;
            pg8::Gemm g{XM, Bt, M, N, D}; pg8::StaticOrder S; S.init(M, N, G, bid);
            pg8::EpiIn E{mixer, (void*)BIG, rs_in, RS + (size_t)9 * M, QSCALE};
            pg8::gemm_phase<pg8::EpiIn, pg8::StaticOrder, true, true>(lds, g, S, E);
        } else if (sub == 1) {
            if (mixer == 0) { bf16* Qb = (bf16*)BIG; bf16* Kb = Qb + (size_t)M * D; bf16* Vb = Kb + (size_t)M * D;
                attn_phase(Qb, Kb, Vb, Vb + (size_t)M * D, lds + wave * 4608, gw, ngw, lane);
            } else if (mixer == 1) { bf16* Hb = (bf16*)BIG; bf16* GATED = Hb + (size_t)M * 2 * D;
                sg_phase(Hb, RS + (size_t)9 * M, args.in[I_SGNG], args.in[I_SGWS], args.in[I_SGB], GATED, lds, G, bid, tid);
            } else { const bf16* Ub = (const bf16*)BIG; bf16* Yb = (bf16*)(BIG + (size_t)M * D * 4);
                if (wave < 2) ssm_phase(Ub, args.in[I_LRE], args.in[I_LIM], args.in[I_LDT], args.in[I_BRE], args.in[I_BIM], args.in[I_CRE], args.in[I_CIM], args.in[I_SSMD], Yb, lds + wave * SSM_WAVE_LDS, bid * 2 + wave, G * 2, lane);
            }
        } else if (sub == 3) {
            const float* cw = args.in[I_CONVW] + (size_t)layer * 3 * FF2; const float* cb = args.in[I_CONVB] + (size_t)layer * FF2;
            pg8::Gemm g{XM, UP_T + (size_t)layer * FF2 * D, M, FF2, D}; pg8::StaticOrder S; S.init(M, FF2, G, bid);
            pg8::EpiUp E{(bf16*)BIG, EDGE, rs_mid, cw, cb, lds + EX_OFF};
            pg8::gemm_phase<pg8::EpiUp, pg8::StaticOrder, true, true>(lds, g, S, E);
            if (layer < 3) {
                const int nun = (M / 256) * (FF2 / 256), maxu = (nun + G - 1) / G; int thr = nun - (maxu - 1) * G; if (thr >= G) thr = 0;
                if (bid >= thr) {
                    const int gwi = (bid - thr) * NWAVES + wave, ngwi = (G - thr) * NWAVES, nl = layer + 1; LAS float* scr = (LAS float*)(lds + wave * 16384);
                    const float* Wa = (nl == 1) ? args.in[I_SGIN] : (nl == 2) ? args.in[I_SSMIN] : args.in[I_WQKV] + (size_t)D * 3 * D;
                    bf16* Ta = (nl == 1) ? SGIN_T : (nl == 2) ? SSMIN_T : WQKV_T + (size_t)3 * D * D; const int Na = (nl == 1) ? 2 * D : (nl == 2) ? D : 3 * D;
                    const float* Wb = (nl == 1) ? args.in[I_SGO] : (nl == 2) ? args.in[I_GLU] : args.in[I_WO] + (size_t)D * D;
                    bf16* Tb = (nl == 1) ? SGO_T : (nl == 2) ? GLU_T : WO_T + (size_t)D * D; const int Nb = (nl == 2) ? 2 * D : D, hb = (nl == 2) ? D : 0;
                    convert4(Wa, norm_g + (size_t)(2 * nl) * D, D, Na, Ta, 0, Wb, D, Nb, Tb, hb, args.in[I_UP] + (size_t)nl * D * FF2, norm_g + (size_t)(2 * nl + 1) * D, D, FF2, UP_T + (size_t)nl * FF2 * D, FF,
                             args.in[I_DOWN] + (size_t)nl * FF * D, FF, D, DOWN_T + (size_t)nl * D * FF, 0, scr, gwi, ngwi, lane);
                }
            }
        } else {
            const bool down = (sub == 4);
            const bf16* A = down ? (const bf16*)BIG : (mixer == 0) ? (const bf16*)BIG + (size_t)3 * M * D : (mixer == 1) ? (const bf16*)BIG + (size_t)M * 2 * D : (const bf16*)(BIG + (size_t)M * D * 4);
            const bf16* Bt = down ? DOWN_T + (size_t)layer * D * FF : (mixer == 0) ? WO_T + (size_t)j * D * D : (mixer == 1) ? SGO_T : GLU_T;
            const bool glu = !down && mixer == 2; const int N = glu ? 2 * D : D, K = down ? FF : D;
            pg8::rss_t* rsn = down ? RS + (size_t)(2 * layer + 2) * M : rs_mid;
            const float* xbase = nullptr;
            pg8::Gemm g{A, Bt, M, N, K}; pg8::StaticOrder S; S.init(M, N, G, bid);
            if (down) ffn_fixup(S, EDGE, args.in[I_CONVW] + (size_t)layer * 3 * FF2, args.in[I_CONVB] + (size_t)layer * FF2, (bf16*)BIG, tid);

            if (down && layer == 3 && fused_final) {
                EpiFinal E{XM, X, args.in[I_FNG], RS + (size_t)8 * M, xbar};
                pg8::gemm_phase<EpiFinal, pg8::StaticOrder, true, true>(lds, g, S, E);
            } else {
                pg8::EpiResid E{xbase, XM, X, rsn, glu, down && layer == 3};
                pg8::gemm_phase<pg8::EpiResid, pg8::StaticOrder, true, true>(lds, g, S, E);
            }
        }
        if (!(fused_final && step == 19)) xcd_barrier(xbar);
    }
    if (!fused_final)
    {
        const f32x4* gr = (const f32x4*)args.in[I_FNG] + lane;
        for (int m = gw0; m < M; m += ngw) {
            f32x4* xr = (f32x4*)(X + (size_t)m * D) + lane; f32x4 v[4]; float s = 0.f;
#pragma unroll
            for (int jj = 0; jj < 4; ++jj) { v[jj] = xr[64 * jj]; s += pg8::sumsq4(v[jj]); }
            const float rs = rsqrtf(wave_sum(s) * (1.0f / 1024.0f) + pg8::RMS_EPS);
#pragma unroll
            for (int jj = 0; jj < 4; ++jj) xr[64 * jj] = v[jj] * rs * gr[64 * jj];
        }
    }
}

extern "C" void kernel_launch(void* const* d_in, const int* in_sizes, int n_in, void* d_out, int out_size, void* d_ws, size_t ws_size, hipStream_t stream) {
    static int grid = 0;
    if (grid == 0) {
        if (n_in != 24 || out_size != M * D || ws_size < WS_END) { fprintf(stderr, "kernel_launch: unexpected problem (n_in %d, out %d, ws %zu)\n", n_in, out_size, ws_size); grid = -1; return; }
        int dev = 0, cus = 0, per_cu = 0;
        hipGetDevice(&dev); hipDeviceGetAttribute(&cus, hipDeviceAttributeMultiprocessorCount, dev);
        if (hipFuncSetAttribute((const void*)trunk_fwd, hipFuncAttributeMaxDynamicSharedMemorySize, LDS_BYTES) != hipSuccess) { fprintf(stderr, "kernel_launch: hipFuncSetAttribute failed\n"); grid = -1; return; }
        if (hipOccupancyMaxActiveBlocksPerMultiprocessor(&per_cu, (const void*)trunk_fwd, NWAVES * 64, LDS_BYTES) != hipSuccess || per_cu < 1) per_cu = 1;
        (void)hipGetLastError();
        grid = cus * 1;
        if (grid <= 0) grid = 256;
    }
    if (grid < 0) return;
    Args a{};
    for (int i = 0; i < 24; ++i) a.in[i] = (const float*)d_in[i];
    a.out = (float*)d_out; a.ws = (unsigned char*)d_ws;
    if (hipMemsetAsync((char*)d_ws + WS_BAR, 0, BAR_BYTES, stream) != hipSuccess) { fprintf(stderr, "kernel_launch: memset of the barrier words failed\n"); return; }
    void* kargs[] = {&a};
    hipError_t e = hipLaunchCooperativeKernel((const void*)trunk_fwd, dim3(grid), dim3(NWAVES * 64), kargs, LDS_BYTES, stream);
    if (e != hipSuccess) fprintf(stderr, "kernel_launch: cooperative launch failed: %s (grid %d)\n", hipGetErrorString(e), grid);
}
```

```cpp
#include <hip/hip_runtime.h>
#include <hip/hip_cooperative_groups.h>
#include <cstdio>
#include <cstdint>
namespace cg = cooperative_groups;
namespace pg8 {
#define PG8_LAS __attribute__((address_space(3)))
typedef unsigned short bf16_t;
typedef short bf16x8 __attribute__((ext_vector_type(8)));
typedef float f32x4 __attribute__((ext_vector_type(4)));
typedef unsigned u32x4 __attribute__((ext_vector_type(4)));
constexpr int BM = 256, BK = 64, HALF = 128, HTB = HALF * BK * 2  , STAGE_BYTES = 8 * HTB, NXCD = 8, WGM = 8;

__host__ __device__ __forceinline__ int lds_byte(int r, int c) { const int st = (r >> 4) * 2 + (c >> 5), rr = r & 15, cc = c & 31, ob = rr * 64 + cc * 2; return st * 1024 + (ob ^ (((ob >> 9) & 1) << 5)); }
__host__ __device__ __forceinline__ void stage_rc(int b, int& R, int& C) { const int st = b / 1024, sb = b % 1024, swz = sb ^ (((sb >> 9) & 1) << 5); R = (st >> 1) * 16 + swz / 64; C = (st & 1) * 32 + (swz % 64) / 2; }
__host__ __device__ __forceinline__ int perm32(int rho) { const int n = rho >> 4, i = rho & 15; return 8 * (i >> 2) + 4 * n + (i & 3); }

struct Unit { int pm, pn; };
struct Gemm { const bf16_t* A; const bf16_t* Bt; int M, N, K; };

struct StaticOrder {
    int nM, nN, nwg, G, c;
    __host__ __device__ void init(int M, int N, int G_, int c_) { nM = M / BM; nN = N / BM; nwg = nM * nN; G = G_; c = c_; }
    __host__ __device__ bool next(int i, Unit& u) const {
        const long L = (long)i * G + c; if (L >= nwg) return false;
        int wgid = (int)L; { const int q = nwg / NXCD, r = nwg % NXCD, xcd = wgid % NXCD, off = wgid / NXCD; wgid = (xcd < r ? xcd * (q + 1) : r * (q + 1) + (xcd - r) * q) + off; }
        const int nig = WGM * nN, gid = wgid / nig, fm = gid * WGM, gsz = (nM - fm) < WGM ? (nM - fm) : WGM;
        u.pm = fm + ((wgid % nig) % gsz); u.pn = (wgid % nig) / gsz; return true;
    }
    __device__ __forceinline__ void a_ready(const Unit&) const {}
    __device__ __forceinline__ void done(const Unit&) const {}
};

__device__ __forceinline__ unsigned cvt_pk_bf16(float lo, float hi) { unsigned r; asm volatile("v_cvt_pk_bf16_f32 %0, %1, %2" : "=v"(r) : "v"(lo), "v"(hi)); return r; }
template <class Epi, class Sched, bool ALIGN_EPI = false, bool SP2 = false>
__device__ __forceinline__ void gemm_phase(PG8_LAS unsigned char* lds, const Gemm g, const Sched& S, const Epi& E) {
    int tid = threadIdx.x; asm volatile("" : "+v"(tid));
    const int wid = __builtin_amdgcn_readfirstlane(tid >> 6), lane = tid & 63, wr = wid >> 2, wc = wid & 3, fr = lane & 15, fq = lane >> 4;
    const int K = g.K, nt = K / BK;
    unsigned voffA[2], voffB[2];
#pragma unroll
    for (int i = 0; i < 2; ++i) { int R, C; stage_rc(tid * 16 + i * 8192, R, C); const int Rb = Epi::PERM ? ((R & ~31) + perm32(R & 31)) : R;
        voffA[i] = (unsigned)(R * K + C) * 2u; voffB[i] = (unsigned)(Rb * K + C) * 2u; }
    const size_t kstep = (size_t)(BK * 2);
    const size_t hstep = (size_t)HALF * K * 2;
    const size_t tstep = 2 * hstep;
    const unsigned ldsw = (unsigned)wid * 1024u;
    const int aoff = lds_byte(wr * 64 + fr, fq * 8), boff = lds_byte(wc * 32 + fr, fq * 8);
#define PG8_SA(b, h) (((b) * 2 + (h)) * HTB)
#define PG8_SB(b, h) ((4 + (b) * 2 + (h)) * HTB)
#define PG8_STAGE(bufoff, gbase, voff) do { _Pragma("unroll") for (int _i = 0; _i < 2; ++_i) \
        __builtin_amdgcn_global_load_lds((const unsigned*)((const char*)(gbase) + (voff)[_i]), (PG8_LAS unsigned*)(lds + (bufoff) + ldsw + _i * 8192), 16, 0, 0); } while (0)
#define PG8_LDA(dst, b, h) do { _Pragma("unroll") for (int m = 0; m < 4; ++m) _Pragma("unroll") for (int k = 0; k < 2; ++k) dst[m][k] = *(const PG8_LAS bf16x8*)(lds + PG8_SA(b, h) + aoff + m * 2048 + k * 1024); } while (0)
#define PG8_LDB(dst, b, h) do { _Pragma("unroll") for (int n = 0; n < 2; ++n) _Pragma("unroll") for (int k = 0; k < 2; ++k) dst[n][k] = *(const PG8_LAS bf16x8*)(lds + PG8_SB(b, h) + boff + n * 2048 + k * 1024); } while (0)
#define PG8_MMA(ai, bj, At, Bt) do { __builtin_amdgcn_s_setprio(1); _Pragma("unroll") for (int m = 0; m < 4; ++m) _Pragma("unroll") for (int n = 0; n < 2; ++n) _Pragma("unroll") for (int k = 0; k < 2; ++k) \
        acc[ai][bj][m][n] = __builtin_amdgcn_mfma_f32_16x16x32_bf16(Bt[n][k], At[m][k], acc[ai][bj][m][n], 0, 0, 0); __builtin_amdgcn_s_setprio(0); } while (0)
#define PG8_WAIT_V(n) asm volatile("s_waitcnt vmcnt(" #n ")" ::: "memory")
#define PG8_WAIT_L(n) asm volatile("s_waitcnt lgkmcnt(" #n ")" ::: "memory")
#define PG8_BAR __builtin_amdgcn_s_barrier()
#define PG8_SCHED __builtin_amdgcn_sched_barrier(0)
    Unit cur, nxt; int ui = 0;
    if (!S.next(0, cur)) return;
    f32x4 acc[2][2][4][2];
#pragma unroll
    for (int a = 0; a < 2; ++a)
#pragma unroll
        for (int b = 0; b < 2; ++b)
#pragma unroll
            for (int m = 0; m < 4; ++m)
#pragma unroll
                for (int n = 0; n < 2; ++n) acc[a][b][m][n] = (f32x4){0.f, 0.f, 0.f, 0.f};
    bf16x8 At[4][2], B0[2][2], B1[2][2];
    const char* cA = (const char*)g.A + (size_t)cur.pm * tstep; const char* cB = (const char*)g.Bt + (size_t)cur.pn * tstep;
    S.a_ready(cur);
    if constexpr (SP2) {
        PG8_STAGE(PG8_SB(0, 0), cB, voffB); PG8_STAGE(PG8_SB(0, 1), cB + hstep, voffB); PG8_STAGE(PG8_SA(0, 0), cA, voffA); PG8_STAGE(PG8_SA(0, 1), cA + hstep, voffA);
        if (wr == 1) PG8_BAR;
        PG8_WAIT_V(2); PG8_BAR;
        PG8_STAGE(PG8_SB(1, 0), cB + kstep, voffB); PG8_STAGE(PG8_SA(1, 0), cA + kstep, voffA); PG8_STAGE(PG8_SB(1, 1), cB + hstep + kstep, voffB);
        PG8_WAIT_V(6); PG8_BAR;
    } else {
        PG8_STAGE(PG8_SB(0, 0), cB, voffB); PG8_STAGE(PG8_SA(0, 0), cA, voffA); PG8_STAGE(PG8_SB(0, 1), cB + hstep, voffB); PG8_STAGE(PG8_SA(0, 1), cA + hstep, voffA);
        if (wr == 1) PG8_BAR;
        PG8_WAIT_V(4); PG8_BAR;
        PG8_STAGE(PG8_SB(1, 0), cB + kstep, voffB); PG8_STAGE(PG8_SA(1, 0), cA + kstep, voffA); PG8_STAGE(PG8_SB(1, 1), cB + hstep + kstep, voffB);
        PG8_WAIT_V(6); PG8_BAR;
    }
    for (;;) {
        const bool has_next = S.next(ui + 1, nxt);
        const char* nA = has_next ? (const char*)g.A + (size_t)nxt.pm * tstep : cA; const char* nB = has_next ? (const char*)g.Bt + (size_t)nxt.pn * tstep : cB;
        for (int t = 0; t < nt; t += 2) {
            const bool last = (t == nt - 2);
            const char* a1 = cA + (size_t)(t + 1) * kstep;
            const char* a2 = last ? nA : cA + (size_t)(t + 2) * kstep; const char* b2 = last ? nB : cB + (size_t)(t + 2) * kstep;
            const char* a3 = a2 + kstep; const char* b3 = b2 + kstep;
            if (last && has_next) S.a_ready(nxt);
            if constexpr (SP2) {
            PG8_LDB(B0, 0, 0); PG8_LDB(B1, 0, 1); PG8_SCHED; PG8_LDA(At, 0, 0); PG8_STAGE(PG8_SA(1, 1), a1 + hstep, voffA);
            PG8_WAIT_V(8); PG8_WAIT_L(0); PG8_BAR; PG8_MMA(0, 0, At, B0); PG8_MMA(0, 1, At, B1); PG8_BAR; PG8_SCHED;
            PG8_LDA(At, 0, 1); PG8_STAGE(PG8_SB(0, 0), b2, voffB); PG8_STAGE(PG8_SB(0, 1), b2 + hstep, voffB); PG8_STAGE(PG8_SA(0, 0), a2, voffA);
            PG8_WAIT_V(8); PG8_WAIT_L(0); PG8_BAR; PG8_MMA(1, 0, At, B0); PG8_MMA(1, 1, At, B1); PG8_BAR; PG8_SCHED;
            PG8_LDB(B0, 1, 0); PG8_LDB(B1, 1, 1); PG8_SCHED; PG8_LDA(At, 1, 0); PG8_STAGE(PG8_SA(0, 1), a2 + hstep, voffA);
            PG8_WAIT_V(8); PG8_WAIT_L(0); PG8_BAR; PG8_MMA(0, 0, At, B0); PG8_MMA(0, 1, At, B1); PG8_BAR; PG8_SCHED;
            PG8_LDA(At, 1, 1); PG8_STAGE(PG8_SB(1, 0), b3, voffB); PG8_STAGE(PG8_SB(1, 1), b3 + hstep, voffB); PG8_STAGE(PG8_SA(1, 0), a3, voffA);
            PG8_WAIT_V(8); PG8_WAIT_L(0); PG8_BAR; PG8_MMA(1, 0, At, B0); PG8_MMA(1, 1, At, B1); PG8_BAR; PG8_SCHED;
            } else {
            PG8_LDB(B0, 0, 0); PG8_SCHED; PG8_LDA(At, 0, 0); PG8_STAGE(PG8_SA(1, 1), a1 + hstep, voffA);
            PG8_WAIT_L(8); PG8_BAR; PG8_WAIT_L(0); PG8_MMA(0, 0, At, B0); PG8_BAR; PG8_SCHED;
            PG8_LDB(B1, 0, 1); PG8_STAGE(PG8_SB(0, 0), b2, voffB);
            PG8_BAR; PG8_WAIT_L(0); PG8_MMA(0, 1, At, B1); PG8_BAR;
            PG8_LDA(At, 0, 1); PG8_STAGE(PG8_SA(0, 0), a2, voffA);
            PG8_BAR; PG8_WAIT_L(0); PG8_MMA(1, 0, At, B0); PG8_BAR; PG8_SCHED;
            PG8_STAGE(PG8_SB(0, 1), b2 + hstep, voffB);
            PG8_WAIT_V(6); PG8_BAR; PG8_MMA(1, 1, At, B1); PG8_BAR;
            PG8_LDB(B0, 1, 0); PG8_SCHED; PG8_LDA(At, 1, 0); PG8_STAGE(PG8_SA(0, 1), a2 + hstep, voffA);
            PG8_WAIT_L(8); PG8_BAR; PG8_WAIT_L(0); PG8_MMA(0, 0, At, B0); PG8_BAR; PG8_SCHED;
            PG8_LDB(B1, 1, 1); PG8_STAGE(PG8_SB(1, 0), b3, voffB);
            PG8_BAR; PG8_WAIT_L(0); PG8_MMA(0, 1, At, B1); PG8_BAR;
            PG8_LDA(At, 1, 1); PG8_STAGE(PG8_SA(1, 0), a3, voffA);
            PG8_BAR; PG8_WAIT_L(0); PG8_MMA(1, 0, At, B0); PG8_BAR; PG8_SCHED;
            PG8_STAGE(PG8_SB(1, 1), b3 + hstep, voffB);
            PG8_WAIT_V(6); PG8_BAR; PG8_MMA(1, 1, At, B1); PG8_BAR;
            }
        }
        if constexpr (ALIGN_EPI) { if (wr == 0) PG8_BAR; }
        if constexpr (!Epi::AFTER_DRAIN) { E(acc, cur, wr, wc, fr, fq); S.done(cur); }
        if (!has_next) break;
#pragma unroll
        for (int a = 0; a < 2; ++a)
#pragma unroll
            for (int b = 0; b < 2; ++b)
#pragma unroll
                for (int m = 0; m < 4; ++m)
#pragma unroll
                    for (int n = 0; n < 2; ++n) acc[a][b][m][n] = (f32x4){0.f, 0.f, 0.f, 0.f};
        cur = nxt; cA = nA; cB = nB; ++ui;
        if constexpr (ALIGN_EPI) { if (wr == 1) PG8_BAR; }
    }
    PG8_WAIT_V(0);
    if constexpr (!ALIGN_EPI) { if (wr == 0) PG8_BAR; }
    PG8_BAR;
    if constexpr (Epi::AFTER_DRAIN) { E.fused(acc, cur, wr, wc, fr, fq, lds, wid, lane); S.done(cur); }
#undef PG8_SA
#undef PG8_SB
#undef PG8_STAGE
#undef PG8_LDA
#undef PG8_LDB
#undef PG8_MMA
#undef PG8_WAIT_V
#undef PG8_WAIT_L
#undef PG8_BAR
#undef PG8_SCHED
}
}

namespace pg8 {
typedef float f32x2 __attribute__((ext_vector_type(2)));
typedef __bf16 bf16x2_t __attribute__((ext_vector_type(2)));
typedef unsigned u32x2v __attribute__((ext_vector_type(2)));
constexpr int MROWS = 16384, DM = 1024, DFF = 2816, DFF2 = 5632;
constexpr float RMS_EPS = 1e-6f;
__device__ __forceinline__ unsigned pkbf(float lo, float hi) { f32x2 v = {lo, hi}; bf16x2_t b = __builtin_convertvector(v, bf16x2_t); return __builtin_bit_cast(unsigned, b); }
__device__ __forceinline__ u32x4 pk8(f32x4 a, f32x4 b) { u32x4 w; w.x = pkbf(a[0], a[1]); w.y = pkbf(a[2], a[3]); w.z = pkbf(b[0], b[1]); w.w = pkbf(b[2], b[3]); return w; }
typedef unsigned long long rss_t;
constexpr float RSS_SCALE = 1048576.0f;
__device__ __forceinline__ rss_t rss_of(float sq) { return (rss_t)(sq * RSS_SCALE + 0.5f); }
__device__ __forceinline__ void rss_add(rss_t* p, float sq) { (void)__hip_atomic_fetch_add(p, rss_of(sq), __ATOMIC_RELAXED, __HIP_MEMORY_SCOPE_AGENT); }
__device__ __forceinline__ float rstd_of(rss_t ss) { return rsqrtf((float)ss * (1.0f / (1024.0f * RSS_SCALE)) + RMS_EPS); }
__device__ __forceinline__ float sigmoidf_fast(float g) { return __builtin_amdgcn_rcpf(1.0f + __expf(-g)); }
__device__ __forceinline__ float gelu_tanh(float x) { const float u = x * (1.5957691216057308f + 0.07135481627159f * x * x); return x * sigmoidf_fast(u); }
__device__ __forceinline__ f32x4 gelu4(f32x4 v) { f32x4 o; o[0] = gelu_tanh(v[0]); o[1] = gelu_tanh(v[1]); o[2] = gelu_tanh(v[2]); o[3] = gelu_tanh(v[3]); return o; }
__device__ __forceinline__ float sumsq4(f32x4 v) { return (v[0] * v[0] + v[1] * v[1]) + (v[2] * v[2] + v[3] * v[3]); }
#define PG8_DPP_FN(name, ctl) __device__ __forceinline__ float name(float x) { float r; asm("s_nop 1\n\tv_mov_b32_dpp %0, %1 " ctl " row_mask:0xf bank_mask:0xf bound_ctrl:1" : "=v"(r) : "v"(x)); return r; }
PG8_DPP_FN(dpp_shr1, "row_shr:1") PG8_DPP_FN(dpp_shr2, "row_shr:2") PG8_DPP_FN(dpp_shl15, "row_shl:15") PG8_DPP_FN(dpp_shl14, "row_shl:14")
__device__ __forceinline__ void taps4(f32x4& y, const f32x4 cur, const f32x4 pv, const f32x4 w1, const f32x4 w0) {
  asm("s_nop 1\n\t"
      "v_fmac_f32_dpp %0, %4, %12 row_shr:1 row_mask:0xf bank_mask:0xf bound_ctrl:1\n\t"
      "v_fmac_f32_dpp %1, %5, %13 row_shr:1 row_mask:0xf bank_mask:0xf bound_ctrl:1\n\t"
      "v_fmac_f32_dpp %2, %6, %14 row_shr:1 row_mask:0xf bank_mask:0xf bound_ctrl:1\n\t"
      "v_fmac_f32_dpp %3, %7, %15 row_shr:1 row_mask:0xf bank_mask:0xf bound_ctrl:1\n\t"
      "v_fmac_f32_dpp %0, %8, %12 row_shl:15 row_mask:0xf bank_mask:0xf bound_ctrl:1\n\t"
      "v_fmac_f32_dpp %1, %9, %13 row_shl:15 row_mask:0xf bank_mask:0xf bound_ctrl:1\n\t"
      "v_fmac_f32_dpp %2, %10, %14 row_shl:15 row_mask:0xf bank_mask:0xf bound_ctrl:1\n\t"
      "v_fmac_f32_dpp %3, %11, %15 row_shl:15 row_mask:0xf bank_mask:0xf bound_ctrl:1\n\t"
      "v_fmac_f32_dpp %0, %4, %16 row_shr:2 row_mask:0xf bank_mask:0xf bound_ctrl:1\n\t"
      "v_fmac_f32_dpp %1, %5, %17 row_shr:2 row_mask:0xf bank_mask:0xf bound_ctrl:1\n\t"
      "v_fmac_f32_dpp %2, %6, %18 row_shr:2 row_mask:0xf bank_mask:0xf bound_ctrl:1\n\t"
      "v_fmac_f32_dpp %3, %7, %19 row_shr:2 row_mask:0xf bank_mask:0xf bound_ctrl:1\n\t"
      "v_fmac_f32_dpp %0, %8, %16 row_shl:14 row_mask:0xf bank_mask:0xf bound_ctrl:1\n\t"
      "v_fmac_f32_dpp %1, %9, %17 row_shl:14 row_mask:0xf bank_mask:0xf bound_ctrl:1\n\t"
      "v_fmac_f32_dpp %2, %10, %18 row_shl:14 row_mask:0xf bank_mask:0xf bound_ctrl:1\n\t"
      "v_fmac_f32_dpp %3, %11, %19 row_shl:14 row_mask:0xf bank_mask:0xf bound_ctrl:1"
      : "+v"(y[0]), "+v"(y[1]), "+v"(y[2]), "+v"(y[3])
      : "v"(cur[0]), "v"(cur[1]), "v"(cur[2]), "v"(cur[3]), "v"(pv[0]), "v"(pv[1]), "v"(pv[2]), "v"(pv[3]),
        "v"(w1[0]), "v"(w1[1]), "v"(w1[2]), "v"(w1[3]), "v"(w0[0]), "v"(w0[1]), "v"(w0[2]), "v"(w0[3]));
}

struct EpiIn {
    static constexpr bool PERM = true, AFTER_DRAIN = false;
    int mode; void* out; const rss_t* rowss; rss_t* rowss_v; float qscale;
    __device__ __forceinline__ void operator()(f32x4 (&acc)[2][2][4][2], const Unit& u, int wr, int wc, int fr, int fq) const {
        asm volatile("" : "+v"(fr), "+v"(fq));
        const int row0 = u.pm * BM + wr * 64 + fr;
        if (mode == 0) {
            int colt = u.pn * BM; const int t = colt >> 10; colt &= 1023;
            bf16_t* base = (bf16_t*)out + (size_t)t * ((size_t)MROWS * DM); const float sc = (t == 0) ? qscale : 1.f;
            const int col0 = colt + wc * 32 + 8 * fq;
#pragma unroll
            for (int ai = 0; ai < 2; ++ai)
#pragma unroll
                for (int m = 0; m < 4; ++m) { const int r = row0 + ai * HALF + m * 16; const float rs = rstd_of(rowss[r]) * sc; bf16_t* rowp = base + (size_t)r * DM + col0;
#pragma unroll
                    for (int bj = 0; bj < 2; ++bj) *(u32x4*)(rowp + bj * HALF) = pk8(acc[ai][bj][m][0] * rs, acc[ai][bj][m][1] * rs);
                    asm volatile("" ::: "memory"); }
        } else if (mode == 1) {
            const int col0 = u.pn * BM + wc * 32 + 8 * fq; const bool vpart = u.pn >= 4;
#pragma unroll
            for (int ai = 0; ai < 2; ++ai)
#pragma unroll
                for (int m = 0; m < 4; ++m) { const int r = row0 + ai * HALF + m * 16; const float rs = rstd_of(rowss[r]); bf16_t* rowp = (bf16_t*)out + (size_t)r * 2048 + col0; float sq = 0.f;
#pragma unroll
                    for (int bj = 0; bj < 2; ++bj) { const f32x4 v0 = gelu4(acc[ai][bj][m][0] * rs), v1 = gelu4(acc[ai][bj][m][1] * rs); sq += sumsq4(v0) + sumsq4(v1); *(u32x4*)(rowp + bj * HALF) = pk8(v0, v1); }
                    if (vpart) { sq += __shfl_xor(sq, 16); sq += __shfl_xor(sq, 32); if (fq == 0) rss_add(rowss_v + r, sq); }
                    asm volatile("" ::: "memory"); }
        } else {
            const int col0 = u.pn * BM + wc * 32 + 8 * fq;
#pragma unroll
            for (int ai = 0; ai < 2; ++ai)
#pragma unroll
                for (int m = 0; m < 4; ++m) { const int r = row0 + ai * HALF + m * 16; const float rs = rstd_of(rowss[r]); bf16_t* rowp = (bf16_t*)out + (size_t)r * DM + col0;
#pragma unroll
                    for (int bj = 0; bj < 2; ++bj) *(u32x4*)(rowp + bj * HALF) = pk8(acc[ai][bj][m][0] * rs, acc[ai][bj][m][1] * rs);
                    asm volatile("" ::: "memory"); }
        }
    }
};
struct EpiResid {
    static constexpr bool PERM = true, AFTER_DRAIN = false;
    const float* base32; bf16_t* XM; float* Xout; rss_t* rowss_next; bool GLU; bool last;
    __device__ __forceinline__ void load_base(size_t off, f32x4& b0, f32x4& b1) const {
        if (base32) { b0 = *(const f32x4*)(base32 + off); b1 = *(const f32x4*)(base32 + off + 4); }
        else { const u32x4 w = *(const u32x4*)(XM + off);
            b0 = (f32x4){__builtin_bit_cast(float, w.x << 16), __builtin_bit_cast(float, w.x & 0xffff0000u), __builtin_bit_cast(float, w.y << 16), __builtin_bit_cast(float, w.y & 0xffff0000u)};
            b1 = (f32x4){__builtin_bit_cast(float, w.z << 16), __builtin_bit_cast(float, w.z & 0xffff0000u), __builtin_bit_cast(float, w.w << 16), __builtin_bit_cast(float, w.w & 0xffff0000u)}; }
    }
    __device__ __forceinline__ void operator()(f32x4 (&acc)[2][2][4][2], const Unit& u, int wr, int wc, int fr, int fq) const {
        asm volatile("" : "+v"(fr), "+v"(fq));
        const int row0 = u.pm * BM + wr * 64 + fr;
        if (!GLU) {
            const int col0 = u.pn * BM + wc * 32 + 8 * fq;
#pragma unroll
            for (int ai = 0; ai < 2; ++ai)
#pragma unroll
                for (int m = 0; m < 4; ++m) { const int r = row0 + ai * HALF + m * 16; float sq = 0.f;
#pragma unroll
                    for (int bj = 0; bj < 2; ++bj) { const size_t off = (size_t)r * DM + col0 + bj * HALF; f32x4 b0, b1; load_base(off, b0, b1);
                        const f32x4 x0 = b0 + acc[ai][bj][m][0], x1 = b1 + acc[ai][bj][m][1];
                        if (last) { *(f32x4*)(Xout + off) = x0; *(f32x4*)(Xout + off + 4) = x1; }
                        else { *(u32x4*)(XM + off) = pk8(x0, x1); sq += sumsq4(x0) + sumsq4(x1); } }
                    if (!last) { sq += __shfl_xor(sq, 16); sq += __shfl_xor(sq, 32); if (fq == 0) rss_add(rowss_next + r, sq); }
                    if (m == 3) asm volatile("" ::: "memory"); }
        } else {
            const int col0 = u.pn * HALF + wc * 32 + 8 * fq;
#pragma unroll
            for (int ai = 0; ai < 2; ++ai)
#pragma unroll
                for (int m = 0; m < 4; ++m) { const int r = row0 + ai * HALF + m * 16; float sq = 0.f; const size_t off = (size_t)r * DM + col0; f32x4 xv[2]; load_base(off, xv[0], xv[1]);
#pragma unroll
                    for (int n = 0; n < 2; ++n) { const f32x4 a = acc[ai][0][m][n], g = acc[ai][1][m][n]; f32x4 v;
#pragma unroll
                        for (int e = 0; e < 4; ++e) v[e] = a[e] * sigmoidf_fast(g[e]);
                        xv[n] = xv[n] + v; sq += sumsq4(xv[n]); }
                    *(u32x4*)(XM + off) = pk8(xv[0], xv[1]);
                    sq += __shfl_xor(sq, 16); sq += __shfl_xor(sq, 32); if (fq == 0) rss_add(rowss_next + r, sq);
                    if (m == 3) asm volatile("" ::: "memory"); }
        }
    }
};
struct EpiUp {
    static constexpr bool PERM = true, AFTER_DRAIN = false;
    bf16_t* ACT; float* EDGE; const rss_t* rowss; const float* cw; const float* cb; PG8_LAS unsigned char* ex;
    __device__ __forceinline__ void operator()(f32x4 (&acc)[2][2][4][2], const Unit& u, int wr, int wc, int fr, int fq) const {
        asm volatile("" : "+v"(fr), "+v"(fq));
        const int row0 = u.pm * BM + wr * 64 + fr;
#pragma unroll
        for (int ai = 0; ai < 2; ++ai)
#pragma unroll
            for (int m = 0; m < 4; ++m) { const float rs = rstd_of(rowss[row0 + ai * HALF + m * 16]);
#pragma unroll
                for (int bj = 0; bj < 2; ++bj)
#pragma unroll
                    for (int n = 0; n < 2; ++n) acc[ai][bj][m][n] = acc[ai][bj][m][n] * rs; }
        PG8_LAS f32x4* EX = (PG8_LAS f32x4*)ex;
        const int slot = ((fr - 14) & 1) * 4 + fq;
        const int ocol = u.pn * HALF + wc * 32 + 8 * fq;
        if (fr >= 14) {
#pragma unroll
            for (int ai = 0; ai < 2; ++ai)
#pragma unroll
                for (int bj = 0; bj < 2; ++bj)
#pragma unroll
                    for (int n = 0; n < 2; ++n) EX[(((((2 * ai + wr) * 4 + wc) * 2 + bj) * 2 + n) * 8) + slot] = acc[ai][bj][3][n];
            if (wr == 1) {
#pragma unroll
                for (int bj = 0; bj < 2; ++bj)
#pragma unroll
                    for (int n = 0; n < 2; ++n) *(f32x4*)(EDGE + (size_t)(u.pm * 4 + 2 + (fr - 14)) * DFF2 + bj * DFF + ocol + 4 * n) = acc[1][bj][3][n];
            }
        }
        if (wr == 0 && fr < 2) {
#pragma unroll
            for (int bj = 0; bj < 2; ++bj)
#pragma unroll
                for (int n = 0; n < 2; ++n) *(f32x4*)(EDGE + (size_t)(u.pm * 4 + fr) * DFF2 + bj * DFF + ocol + 4 * n) = acc[0][bj][0][n];
        }
        asm volatile("s_waitcnt lgkmcnt(0)" ::: "memory"); __builtin_amdgcn_s_barrier(); asm volatile("" ::: "memory");
        const bool bstart = (u.pm & 7) == 0;
#pragma unroll
        for (int n = 0; n < 2; ++n) {
            f32x4 w0[2], w1[2], w2[2], bb[2];
#pragma unroll
            for (int bj = 0; bj < 2; ++bj) { const int oc = bj * DFF + ocol + 4 * n;
                w0[bj] = *(const f32x4*)(cw + oc); w1[bj] = *(const f32x4*)(cw + DFF2 + oc); w2[bj] = *(const f32x4*)(cw + 2 * DFF2 + oc); bb[bj] = *(const f32x4*)(cb + oc); }
#pragma unroll
            for (int ai = 0; ai < 2; ++ai) {
                const int pblk = 2 * ai + wr - 1;
                f32x4 prev[2];
#pragma unroll
                for (int bj = 0; bj < 2; ++bj) prev[bj] = (pblk >= 0) ? EX[((((pblk * 4 + wc) * 2 + bj) * 2 + n) * 8) + slot] : (f32x4){0.f, 0.f, 0.f, 0.f};
#pragma unroll
                for (int m = 0; m < 4; ++m) {
                    f32x4 y[2];
#pragma unroll
                    for (int bj = 0; bj < 2; ++bj) { const f32x4 cur = acc[ai][bj][m][n]; const f32x4 pv = (m == 0) ? prev[bj] : acc[ai][bj][m > 0 ? m - 1 : 0][n];
                        y[bj] = w2[bj] * cur + bb[bj]; taps4(y[bj], cur, pv, w1[bj], w0[bj]); }
                    f32x4 o;
#pragma unroll
                    for (int e = 0; e < 4; ++e) { const float g = y[1][e]; o[e] = g * sigmoidf_fast(g) * y[0][e]; }
                    const bool skip = (ai == 0) && (m == 0) && (wr == 0) && (fr < 2) && !bstart;
                    if (!skip) { u32x2v w; w.x = pkbf(o[0], o[1]); w.y = pkbf(o[2], o[3]); *(u32x2v*)(ACT + (size_t)(row0 + ai * HALF + m * 16) * DFF + ocol + 4 * n) = w; }
                }
                asm volatile("" ::: "memory");
            }
        }
    }
};
}

#define LAS __attribute__((address_space(3)))
typedef unsigned short bf16;
typedef unsigned v4u __attribute__((ext_vector_type(4)));
typedef unsigned v2u __attribute__((ext_vector_type(2)));
typedef float f32x4 __attribute__((ext_vector_type(4)));
typedef float f32x16 __attribute__((ext_vector_type(16)));
typedef short bf16x8 __attribute__((ext_vector_type(8)));
typedef short s16x4 __attribute__((ext_vector_type(4)));
typedef short v4i16_t __attribute__((ext_vector_type(4)));
#define MFMA32(a, b, c) __builtin_amdgcn_mfma_f32_32x32x16_bf16((a), (b), (c), 0, 0, 0)
#define MFMA16(a, b, c) __builtin_amdgcn_mfma_f32_16x16x32_bf16((a), (b), (c), 0, 0, 0)
constexpr int NWAVES = 8;
constexpr int M = 16384, D = 1024, SEQ = 2048, FF = 2816, FF2 = 5632;
constexpr size_t MiB = 1u << 20;
constexpr size_t WS_RS = 0;
constexpr size_t WS_WQKV = 2 * MiB, WS_WO = 14 * MiB, WS_SGIN = 18 * MiB, WS_SGO = 22 * MiB, WS_SSMIN = 24 * MiB, WS_GLU = 26 * MiB, WS_UP = 30 * MiB, WS_DOWN = 74 * MiB;
constexpr size_t WS_XM = 96 * MiB, WS_EDGE = 128 * MiB, WS_BIG = 134 * MiB, WS_END = 262 * MiB;
constexpr int RING_BYTES = 131072, EX_OFF = RING_BYTES, MISC_OFF = EX_OFF + 8192, LDS_BYTES = 147456, SSM_WAVE_LDS = 18432;
constexpr size_t WS_BAR = MiB + MiB / 2, BAR_BYTES = 16384;
constexpr float QSCALE = 0.125f * 1.4426950408889634f;

__device__ __forceinline__ float wave_sum(float v) {
#pragma unroll
    for (int o = 1; o < 64; o <<= 1) v += __shfl_xor(v, o);
    return v;
}
__device__ __forceinline__ unsigned pk2(float lo, float hi) { return pg8::pkbf(lo, hi); }
__device__ __forceinline__ bf16x8 pack8(const float* v) { v4u w; w.x = pk2(v[0], v[1]); w.y = pk2(v[2], v[3]); w.z = pk2(v[4], v[5]); w.w = pk2(v[6], v[7]); return __builtin_bit_cast(bf16x8, w); }
__device__ __forceinline__ float bf_lo(unsigned w) { return __builtin_bit_cast(float, w << 16); }
__device__ __forceinline__ float bf_hi(unsigned w) { return __builtin_bit_cast(float, w & 0xffff0000u); }
__device__ __forceinline__ s16x4 vtr(LAS const unsigned char* p) { return __builtin_bit_cast(s16x4, __builtin_amdgcn_ds_read_tr16_b64_v4i16((LAS v4i16_t*)p)); }
__device__ __forceinline__ int crow(int i, int h) { return (i & 3) + 8 * (i >> 2) + 4 * h; }

__device__ __forceinline__ void transpose_item(const float* W, const float* gk, int K, int N, bf16* WT, int half, LAS float* scr, int item, int lane) {
    const int nblk = N / 32, kb = item / nblk, nb = item % nblk, k0 = 64 * kb, n0 = 32 * nb;
    int d0 = n0; if (half > 0) { const int cc = n0 % half; d0 = 256 * (cc / 128) + 128 * (n0 / half) + (cc % 128); }
    float wv[32];
#pragma unroll
    for (int i = 0; i < 32; ++i) wv[i] = W[(size_t)(k0 + 2 * i + (lane >> 5)) * N + n0 + (lane & 31)];
    if (gk) {
#pragma unroll
        for (int i = 0; i < 32; ++i) wv[i] *= gk[k0 + 2 * i + (lane >> 5)];
    }
#pragma unroll
    for (int i = 0; i < 32; ++i) scr[(2 * i + (lane >> 5)) * 33 + (lane & 31)] = wv[i];
    asm volatile("s_waitcnt lgkmcnt(0)" ::: "memory");
    const int c = lane & 7;
#pragma unroll
    for (int j = 0; j < 4; ++j) { const int n = (lane >> 3) + 8 * j; const LAS float* s = scr + (8 * c) * 33 + n;
        v4u o; o.x = pk2(s[0 * 33], s[1 * 33]); o.y = pk2(s[2 * 33], s[3 * 33]); o.z = pk2(s[4 * 33], s[5 * 33]); o.w = pk2(s[6 * 33], s[7 * 33]);
        *(v4u*)(WT + (size_t)(d0 + n) * K + k0 + 8 * c) = o; }
    asm volatile("s_waitcnt lgkmcnt(0)" ::: "memory");
}
__device__ __forceinline__ void convert_matrix(const float* W, const float* gk, int K, int N, bf16* WT, int half, LAS float* scr, int gw, int ngw, int lane) {
    asm volatile("" : "+v"(lane));
    const int items = (K / 64) * (N / 32);
    for (int it = gw; it < items; it += ngw) transpose_item(W, gk, K, N, WT, half, scr, it, lane);
}

__device__ __forceinline__ void convert4(const float* W0, const float* g0, int K0, int N0, bf16* T0, int h0, const float* W1, int K1, int N1, bf16* T1, int h1,
                                         const float* W2, const float* g2, int K2, int N2, bf16* T2, int h2, const float* W3, int K3, int N3, bf16* T3, int h3, LAS float* scr, int gw, int ngw, int lane) {
    asm volatile("" : "+v"(lane));
    const int n0 = (K0 / 64) * (N0 / 32), n1 = (K1 / 64) * (N1 / 32), n2 = (K2 / 64) * (N2 / 32), n3 = (K3 / 64) * (N3 / 32);
    for (int it = gw; it < n0 + n1 + n2 + n3; it += ngw) {
        int r = it;
        if (r < n0) { transpose_item(W0, g0, K0, N0, T0, h0, scr, r, lane); continue; } r -= n0;
        if (r < n1) { transpose_item(W1, nullptr, K1, N1, T1, h1, scr, r, lane); continue; } r -= n1;
        if (r < n2) { transpose_item(W2, g2, K2, N2, T2, h2, scr, r, lane); continue; } r -= n2;
        transpose_item(W3, nullptr, K3, N3, T3, h3, scr, r, lane);
    }
}

__device__ __forceinline__ void attn_phase(const bf16* Qb, const bf16* Kb, const bf16* Vb, bf16* Ob, LAS unsigned char* vbuf, int gwave, int ngw, int lane) {
    asm volatile("" : "+v"(lane));
    const int r = lane & 31, h = lane >> 5, i16 = lane & 15, g16 = lane >> 4, tq = i16 >> 2, tp = i16 & 3;
    const int troff = tq * 144 + (16 * (g16 & 1)) * 2 + 8 * tp;
    bf16x8 qn[4], kn[4]; v4u vn[4];
    if (gwave < 8192) { const int qb = gwave & 63, bh = gwave >> 6, hd = bh & 15; const size_t rowbase = (size_t)(bh >> 4) * SEQ;
        const bf16* qp = Qb + (rowbase + qb * 32 + r) * D + hd * 64 + 8 * h; const bf16* kp0 = Kb + (rowbase + qb * 32 + r) * D + hd * 64 + 8 * h;
        const bf16* vp0 = Vb + (rowbase + qb * 32 + (lane >> 3)) * D + hd * 64 + (lane & 7) * 8;
#pragma unroll
        for (int kk = 0; kk < 4; ++kk) { qn[kk] = *(const bf16x8*)(qp + 16 * kk); kn[kk] = *(const bf16x8*)(kp0 + 16 * kk); }
#pragma unroll
        for (int i = 0; i < 4; ++i) vn[i] = *(const v4u*)(vp0 + (size_t)(8 * i) * D); }
    for (int unit = gwave; unit < 8192; unit += ngw) {
        const int qb = unit & 63, bh = unit >> 6, hd = bh & 15; const size_t rowbase = (size_t)(bh >> 4) * SEQ;
        bf16x8 qf[4];
#pragma unroll
        for (int kk = 0; kk < 4; ++kk) qf[kk] = qn[kk];
        bf16x8 k2[4]; v4u v2[4];
        { const int un = (unit + ngw < 8192) ? unit + ngw : unit; const int qb2 = un & 63, bh2 = un >> 6, hd2 = bh2 & 15; const size_t rb2 = (size_t)(bh2 >> 4) * SEQ;
          const bf16* qp = Qb + (rb2 + qb2 * 32 + r) * D + hd2 * 64 + 8 * h; const bf16* kp0 = Kb + (rb2 + qb2 * 32 + r) * D + hd2 * 64 + 8 * h;
          const bf16* vp0 = Vb + (rb2 + qb2 * 32 + (lane >> 3)) * D + hd2 * 64 + (lane & 7) * 8;
#pragma unroll
          for (int kk = 0; kk < 4; ++kk) { qn[kk] = *(const bf16x8*)(qp + 16 * kk); k2[kk] = *(const bf16x8*)(kp0 + 16 * kk); }
#pragma unroll
          for (int i = 0; i < 4; ++i) v2[i] = *(const v4u*)(vp0 + (size_t)(8 * i) * D); }
        f32x16 o0, o1;
#pragma unroll
        for (int i = 0; i < 16; ++i) { o0[i] = 0.f; o1[i] = 0.f; }
        float srow = 1.f;
        const bf16* kbase = Kb + (rowbase + r) * D + hd * 64 + 8 * h;
        const bf16* vbase = Vb + (rowbase + (lane >> 3)) * D + hd * 64 + (lane & 7) * 8;
        for (int kt = qb; kt >= 0; --kt) {
            bf16x8 kf[4];
#pragma unroll
            for (int kk = 0; kk < 4; ++kk) kf[kk] = kn[kk];
#pragma unroll
            for (int i = 0; i < 4; ++i) *(LAS v4u*)(vbuf + ((lane >> 3) + 8 * i) * 144 + (lane & 7) * 16) = vn[i];
            { const int kp = kt > 0 ? kt - 1 : 0;
#pragma unroll
              for (int kk = 0; kk < 4; ++kk) kn[kk] = *(const bf16x8*)(kbase + (size_t)kp * 32 * D + 16 * kk);
#pragma unroll
              for (int i = 0; i < 4; ++i) vn[i] = *(const v4u*)(vbase + ((size_t)kp * 32 + 8 * i) * D); }
            f32x16 x;
#pragma unroll
            for (int i = 0; i < 16; ++i) x[i] = 0.f;
#pragma unroll
            for (int kk = 0; kk < 4; ++kk) x = MFMA32(kf[kk], qf[kk], x);
            const bool diag = (kt == qb);
            float be[16], om[16];
#pragma unroll
            for (int i = 0; i < 16; ++i) {
                const float z = x[i];
                const float e = __builtin_amdgcn_exp2f(-fabsf(z));
                const float rr = __builtin_amdgcn_rcpf(1.0f + e), er = e * rr;
                float bv = (z >= 0.f) ? rr : er, ov = (z >= 0.f) ? er : rr;
                if (diag) { const bool valid = crow(i, h) < r; bv = valid ? bv : 0.f; ov = valid ? ov : 1.f; }
                be[i] = bv; om[i] = ov;
            }
            float within[16], gown[4], goth[4];
#pragma unroll
            for (int q = 0; q < 4; ++q) { const float w3 = om[4 * q + 3], w2 = w3 * om[4 * q + 2], w1 = w2 * om[4 * q + 1];
                within[4 * q + 3] = 1.f; within[4 * q + 2] = w3; within[4 * q + 1] = w2; within[4 * q] = w1; gown[q] = w1 * om[4 * q]; }
#pragma unroll
            for (int q = 0; q < 4; ++q) goth[q] = __shfl_xor(gown[q], 32);
            const float T0 = gown[0] * goth[0], T1 = gown[1] * goth[1], T2 = gown[2] * goth[2], T3 = gown[3] * goth[3];
            float after[4]; after[3] = 1.f; after[2] = T3; after[1] = T3 * T2; after[0] = after[1] * T1;
            float w[16];
#pragma unroll
            for (int q = 0; q < 4; ++q) { const float basec = srow * after[q] * (h == 0 ? goth[q] : 1.f);
#pragma unroll
                for (int e = 0; e < 4; ++e) w[4 * q + e] = be[4 * q + e] * (basec * within[4 * q + e]); }
            srow *= after[0] * T0;
            const bf16x8 pf0 = pack8(w), pf1 = pack8(w + 8);
            asm volatile("s_waitcnt lgkmcnt(0)" ::: "memory");
#pragma unroll
            for (int s = 0; s < 2; ++s) {
                const bf16x8 pf = s ? pf1 : pf0;
#pragma unroll
                for (int db = 0; db < 2; ++db) {
                    const s16x4 lo = vtr(vbuf + (16 * s + 4 * h) * 144 + 64 * db + troff), hi = vtr(vbuf + (16 * s + 8 + 4 * h) * 144 + 64 * db + troff);
                    const bf16x8 a = __builtin_shufflevector(lo, hi, 0, 1, 2, 3, 4, 5, 6, 7);
                    if (db == 0) o0 = MFMA32(a, pf, o0); else o1 = MFMA32(a, pf, o1);
                }
            }
            asm volatile("s_waitcnt lgkmcnt(0)" ::: "memory");
            if (__all(srow < 5.421010862427522e-20f)) break;
        }
        bf16* op = Ob + (rowbase + qb * 32 + r) * D + hd * 64 + 4 * h;
#pragma unroll
        for (int g = 0; g < 4; ++g) {
            v2u a; a.x = pk2(o0[4 * g], o0[4 * g + 1]); a.y = pk2(o0[4 * g + 2], o0[4 * g + 3]); *(v2u*)(op + 8 * g) = a;
            v2u b; b.x = pk2(o1[4 * g], o1[4 * g + 1]); b.y = pk2(o1[4 * g + 2], o1[4 * g + 3]); *(v2u*)(op + 32 + 8 * g) = b;
        }
#pragma unroll
        for (int kk = 0; kk < 4; ++kk) kn[kk] = k2[kk];
#pragma unroll
        for (int i = 0; i < 4; ++i) vn[i] = v2[i];
    }
}

__device__ __forceinline__ void sg_phase(const bf16* H, const pg8::rss_t* rowss_v, const float* vg, const float* Ws, const float* bs, bf16* GATED, LAS unsigned char* lds, int G, int bid, int tid) {
    asm volatile("" : "+v"(tid));
    const int wave = tid >> 6, lane = tid & 63, tb = wave & 3, dh = wave >> 2;
    const int r = lane & 31, h = lane >> 5, i16 = lane & 15, g16 = lane >> 4, tq = i16 >> 2, tp = i16 & 3;
    const int troff = tq * 272 + (16 * (g16 & 1)) * 2 + 8 * tp;
    for (int unit = bid; unit < 1024; unit += G) {
        const int g = unit & 7; const size_t rowbase = (size_t)(unit >> 3) * 128;
#pragma unroll
        for (int i = 0; i < 4; ++i) { const int s = (tid >> 4) + 32 * i, ch = tid & 15; const size_t row = rowbase + s;
            const v4u raw = *(const v4u*)(H + row * 2048 + 1024 + g * 128 + ch * 8); const float rs = pg8::rstd_of(rowss_v[row]);
            const f32x4 g0 = *(const f32x4*)(vg + g * 128 + ch * 8), g1 = *(const f32x4*)(vg + g * 128 + ch * 8 + 4);
            v4u o; o.x = pk2(bf_lo(raw.x) * rs * g0[0], bf_hi(raw.x) * rs * g0[1]); o.y = pk2(bf_lo(raw.y) * rs * g0[2], bf_hi(raw.y) * rs * g0[3]);
            o.z = pk2(bf_lo(raw.z) * rs * g1[0], bf_hi(raw.z) * rs * g1[1]); o.w = pk2(bf_lo(raw.w) * rs * g1[2], bf_hi(raw.w) * rs * g1[3]);
            *(LAS v4u*)(lds + s * 272 + ch * 16) = o; }
        const int t = 32 * tb + r;
        f32x4 wq0[8], wq1[8];
        { const float* wrow = Ws + ((size_t)(g * 128 + t) * 128 + 8 * h);
#pragma unroll
          for (int kk = 0; kk < 8; ++kk) { wq0[kk] = *(const f32x4*)(wrow + 16 * kk); wq1[kk] = *(const f32x4*)(wrow + 16 * kk + 4); } }
        __syncthreads();
        f32x16 a0, a1;
#pragma unroll
        for (int i = 0; i < 16; ++i) { a0[i] = 0.f; a1[i] = 0.f; }
#pragma unroll
        for (int kk = 0; kk < 8; ++kk) {
            if (kk <= 2 * tb + 1) {
            const int sb = 16 * kk + 8 * h; const f32x4 w0 = wq0[kk], w1 = wq1[kk]; float wv[8];
#pragma unroll
            for (int j = 0; j < 4; ++j) { wv[j] = (sb + j <= t) ? w0[j] : 0.f; wv[4 + j] = (sb + 4 + j <= t) ? w1[j] : 0.f; }
            const bf16x8 bfr = pack8(wv);
#pragma unroll
            for (int db = 0; db < 2; ++db) { const int dbk = 2 * dh + db;
                const s16x4 lo = vtr(lds + (16 * kk + 8 * h) * 272 + 64 * dbk + troff), hi = vtr(lds + (16 * kk + 8 * h + 4) * 272 + 64 * dbk + troff);
                const bf16x8 a = __builtin_shufflevector(lo, hi, 0, 1, 2, 3, 4, 5, 6, 7);
                if (db == 0) a0 = MFMA32(a, bfr, a0); else a1 = MFMA32(a, bfr, a1); }
            }
        }
        const size_t row = rowbase + t; const float bias = bs[g * 128 + t];
#pragma unroll
        for (int db = 0; db < 2; ++db)
#pragma unroll
            for (int gq = 0; gq < 4; ++gq) { const int d0 = 32 * (2 * dh + db) + 8 * gq + 4 * h;
                const v2u ur = *(const v2u*)(H + row * 2048 + g * 128 + d0);
                const float s0 = (db ? a1[4 * gq] : a0[4 * gq]) + bias, s1 = (db ? a1[4 * gq + 1] : a0[4 * gq + 1]) + bias, s2 = (db ? a1[4 * gq + 2] : a0[4 * gq + 2]) + bias, s3 = (db ? a1[4 * gq + 3] : a0[4 * gq + 3]) + bias;
                v2u o; o.x = pk2(bf_lo(ur.x) * s0, bf_hi(ur.x) * s1); o.y = pk2(bf_lo(ur.y) * s2, bf_hi(ur.y) * s3);
                *(v2u*)(GATED + row * D + g * 128 + d0) = o; }
        __syncthreads();
    }
}

__device__ __forceinline__ void sincos_cw(float x, float& s, float& c) {
    const float k = rintf(x * 0.6366197723675814f);
    float rr = fmaf(-k, 1.5707963705062866f, x); rr = fmaf(-k, -4.371139000186243e-08f, rr);
    const int q = ((int)k) & 3; const float r2 = rr * rr;
    const float sp = rr + rr * r2 * (-1.6666667163e-1f + r2 * (8.3333337680e-3f + r2 * (-1.9841270114e-4f + r2 * 2.7557314297e-6f)));
    const float cp = 1.f + r2 * (-0.5f + r2 * (4.1666667908e-2f + r2 * (-1.3888889225e-3f + r2 * (2.4801587642e-5f + r2 * (-2.7557319224e-7f)))));
    s = (q == 0) ? sp : (q == 1) ? cp : (q == 2) ? -sp : -cp;
    c = (q == 0) ? cp : (q == 1) ? -sp : (q == 2) ? -cp : sp;
}
__device__ __forceinline__ void ssm_phase(const bf16* U, const float* lam_re, const float* lam_im, const float* log_dt, const float* b_re, const float* b_im, const float* c_re, const float* c_im,
                                          const float* d_skip, bf16* Y, LAS unsigned char* ldsw, int item0, int istride, int lane) {
    asm volatile("" : "+v"(lane));
    const int r = lane & 31, hh = lane >> 5, hc = lane & 15, fq = lane >> 4;
    const int i16 = lane & 15, tq = i16 >> 2, tp = i16 & 3;
    for (int item = item0; item < 512; item += istride) {
        const int b = item >> 6, g = item & 63;
        const float lr = fminf(lam_re[g * 64 + lane], -1e-4f), li = lam_im[g * 64 + lane], dt = expf(log_dt[g]), mag = expf(dt * lr);
        float sn, cs; sincos_cw(dt * li, sn, cs);
        const float ar = mag * cs, ai = mag * sn, den = lr * lr + li * li;
        const float cre = ((ar - 1.0f) * lr + ai * li) / den, cim = (ai * lr - (ar - 1.0f) * li) / den;
        bf16x8 bfre[2], bfim[2];
#pragma unroll
        for (int pb = 0; pb < 2; ++pb) { const int pp = 32 * pb + r; const float cr = __shfl(cre, pp), ci = __shfl(cim, pp);
            const float* brp = b_re + ((size_t)(g * 64 + pp) * 16 + 8 * hh); const float* bip = b_im + ((size_t)(g * 64 + pp) * 16 + 8 * hh);
            const f32x4 br0 = *(const f32x4*)brp, br1 = *(const f32x4*)(brp + 4), bi0 = *(const f32x4*)bip, bi1 = *(const f32x4*)(bip + 4);
            float re[8], im[8];
#pragma unroll
            for (int j = 0; j < 4; ++j) { re[j] = cr * br0[j] - ci * bi0[j]; im[j] = cr * bi0[j] + ci * br0[j]; re[4 + j] = cr * br1[j] - ci * bi1[j]; im[4 + j] = cr * bi1[j] + ci * br1[j]; }
            bfre[pb] = pack8(re); bfim[pb] = pack8(im); }
        bf16x8 cf[4];
#pragma unroll
        for (int kk = 0; kk < 4; ++kk) { const int kx0 = 32 * kk + 8 * fq; const float* src = (kk < 2) ? (c_re + ((size_t)(g * 16 + hc) * 64 + kx0)) : (c_im + ((size_t)(g * 16 + hc) * 64 + kx0 - 64));
            const f32x4 c0 = *(const f32x4*)src, c1 = *(const f32x4*)(src + 4); const float sg = (kk < 2) ? 1.f : -1.f; float cv[8];
#pragma unroll
            for (int j = 0; j < 4; ++j) { cv[j] = sg * c0[j]; cv[4 + j] = sg * c1[j]; }
            cf[kk] = pack8(cv); }
        const f32x4 dsk = *(const f32x4*)(d_skip + g * 16 + 4 * fq);
        float xr = 0.f, xi = 0.f;
        const bf16* ubase = U + ((size_t)b * SEQ) * D + g * 16;
        const bf16* upA = ubase + (size_t)r * D + 8 * hh;
        const bf16* upE = ubase + (size_t)hc * D + 4 * fq;
        bf16x8 nuf = *(const bf16x8*)upA; v2u ne0 = *(const v2u*)upE, ne1 = *(const v2u*)(upE + (size_t)16 * D);
        for (int sub = 0; sub < 64; ++sub) {
            const size_t t0 = (size_t)b * SEQ + sub * 32;
            const bf16x8 uf = nuf; const v2u e0 = ne0, e1 = ne1;
            { const int sn = (sub < 63) ? sub + 1 : 63; const size_t o = (size_t)sn * 32 * D;
              nuf = *(const bf16x8*)(upA + o); ne0 = *(const v2u*)(upE + o); ne1 = *(const v2u*)(upE + o + (size_t)16 * D); }
            f32x16 zero;
#pragma unroll
            for (int i = 0; i < 16; ++i) zero[i] = 0.f;
#pragma unroll
            for (int xb = 0; xb < 4; ++xb) { const f32x16 d = MFMA32(uf, (xb == 0 ? bfre[0] : xb == 1 ? bfre[1] : xb == 2 ? bfim[0] : bfim[1]), zero);
#pragma unroll
                for (int q = 0; q < 4; ++q) *(LAS v4u*)(ldsw + (32 * xb + r) * 144 + (8 * q + 4 * hh) * 4) = __builtin_bit_cast(v4u, (f32x4){d[4 * q], d[4 * q + 1], d[4 * q + 2], d[4 * q + 3]}); }
            asm volatile("s_waitcnt lgkmcnt(0)" ::: "memory");
            f32x4 cbr[2], cbi[2], nbr[2], nbi[2];
            const LAS unsigned char* rre = ldsw + lane * 144; const LAS unsigned char* rim = ldsw + (64 + lane) * 144;
#pragma unroll
            for (int k = 0; k < 2; ++k) { cbr[k] = __builtin_bit_cast(f32x4, *(const LAS v4u*)(rre + 16 * k)); cbi[k] = __builtin_bit_cast(f32x4, *(const LAS v4u*)(rim + 16 * k)); }
#pragma unroll
            for (int bt = 0; bt < 4; ++bt) {
                if (bt < 3) {
#pragma unroll
                    for (int k = 0; k < 2; ++k) { nbr[k] = __builtin_bit_cast(f32x4, *(const LAS v4u*)(rre + 32 * (bt + 1) + 16 * k)); nbi[k] = __builtin_bit_cast(f32x4, *(const LAS v4u*)(rim + 32 * (bt + 1) + 16 * k)); }
                }
                float xrs[8], xis[8];
#pragma unroll
                for (int k = 0; k < 8; ++k) { const float nxr = fmaf(ar, xr, fmaf(-ai, xi, cbr[k >> 2][k & 3])), nxi = fmaf(ar, xi, fmaf(ai, xr, cbi[k >> 2][k & 3])); xr = nxr; xi = nxi; xrs[k] = xr; xis[k] = xi; }
                {
                    v4u wr_, wi_;
                    wr_.x = pk2(xrs[0], xrs[1]); wr_.y = pk2(xrs[2], xrs[3]); wr_.z = pk2(xrs[4], xrs[5]); wr_.w = pk2(xrs[6], xrs[7]);
                    wi_.x = pk2(xis[0], xis[1]); wi_.y = pk2(xis[2], xis[3]); wi_.z = pk2(xis[4], xis[5]); wi_.w = pk2(xis[6], xis[7]);
                    *(LAS v4u*)(ldsw + lane * 144 + 16 * bt) = wr_; *(LAS v4u*)(ldsw + (64 + lane) * 144 + 16 * bt) = wi_;
                }
#pragma unroll
                for (int k = 0; k < 2; ++k) { cbr[k] = nbr[k]; cbi[k] = nbi[k]; }
            }
            asm volatile("s_waitcnt lgkmcnt(0)" ::: "memory");
#pragma unroll
            for (int tb = 0; tb < 2; ++tb) { f32x4 acc = {0.f, 0.f, 0.f, 0.f};
#pragma unroll
                for (int kk = 0; kk < 4; ++kk) { const LAS unsigned char* xp = ldsw + (32 * kk + 8 * fq + tq) * 144 + 32 * tb + 8 * tp;
                    const s16x4 lo = vtr(xp), hi = vtr(xp + 4 * 144); const bf16x8 xf = __builtin_shufflevector(lo, hi, 0, 1, 2, 3, 4, 5, 6, 7); acc = MFMA16(cf[kk], xf, acc); }
                const size_t row = t0 + 16 * tb + hc; const v2u ur = tb ? e1 : e0; const f32x4 u4 = {bf_lo(ur.x), bf_hi(ur.x), bf_lo(ur.y), bf_hi(ur.y)};
                const f32x4 y = pg8::gelu4(acc + dsk * u4);
                v2u o; o.x = pk2(y[0], y[1]); o.y = pk2(y[2], y[3]); *(v2u*)(Y + row * D + g * 16 + 4 * fq) = o; }
            asm volatile("s_waitcnt lgkmcnt(0)" ::: "memory");
        }
    }
}

__device__ __forceinline__ void ffn_fixup(const pg8::StaticOrder& S, const float* EDGE, const float* cw, const float* cb, bf16* ACT, int tid) {
    asm volatile("" : "+v"(tid));
    pg8::Unit u;
    for (int i = 0; S.next(i, u); ++i) {
        const int pm = u.pm; if ((pm & 7) == 0) continue;
        const float* L0 = EDGE + (size_t)((pm - 1) * 4 + 2) * FF2; const float* L1 = L0 + FF2; const float* F0 = EDGE + (size_t)(pm * 4) * FF2; const float* F1 = F0 + FF2;
        for (int idx = tid; idx < 2 * (FF / 4); idx += NWAVES * 64) { const int rr = idx / (FF / 4), c = 4 * (idx - rr * (FF / 4)); f32x4 y[2];
#pragma unroll
            for (int bj = 0; bj < 2; ++bj) { const int oc = bj * FF + c;
                const f32x4 w0 = *(const f32x4*)(cw + oc), w1 = *(const f32x4*)(cw + FF2 + oc), w2 = *(const f32x4*)(cw + 2 * FF2 + oc), bb = *(const f32x4*)(cb + oc);
                const f32x4 l1 = *(const f32x4*)(L1 + oc), f0 = *(const f32x4*)(F0 + oc);
                y[bj] = (rr == 0) ? (w0 * *(const f32x4*)(L0 + oc) + w1 * l1 + w2 * f0 + bb) : (w0 * l1 + w1 * f0 + w2 * *(const f32x4*)(F1 + oc) + bb); }
            v2u o; float ov[4];
#pragma unroll
            for (int e = 0; e < 4; ++e) { const float g = y[1][e]; ov[e] = g * pg8::sigmoidf_fast(g) * y[0][e]; }
            o.x = pk2(ov[0], ov[1]); o.y = pk2(ov[2], ov[3]);
            *(v2u*)(ACT + (size_t)(pm * 256 + rr) * FF + c) = o; }
    }
    asm volatile("s_waitcnt vmcnt(0)" ::: "memory");
    __syncthreads();
}

#define XB_TMO      128
#define XB_XCNT(j)  (256  + 64 * (j))
#define XB_XSUB(j)  (1280 + 64 * (j))
#define XB_XGEN(j)  (2304 + 64 * (j))
#define XB_TOP      3328
#define XB_TOPGEN   3392
#define XCD_BAR_WORDS 3456
#define XB_SPIN_CAP (1u << 18)

__device__ __forceinline__ unsigned xb_ld(unsigned* p)              { return __hip_atomic_load(p, __ATOMIC_RELAXED, __HIP_MEMORY_SCOPE_AGENT); }
__device__ __forceinline__ unsigned xb_add(unsigned* p, unsigned v) { return __hip_atomic_fetch_add(p, v, __ATOMIC_RELAXED, __HIP_MEMORY_SCOPE_AGENT); }
__device__ __forceinline__ unsigned xb_xcc_id() { return (unsigned)__builtin_amdgcn_s_getreg((3 << 11) | 20) & 0xFu; }
#define XB_SPIN(cond, bar) do { unsigned _sp = 0; while (cond) { __builtin_amdgcn_s_sleep(1); \
    if ((++_sp & 255u) == 0u) { if (xb_ld(&(bar)[XB_TMO])) break; if (_sp > XB_SPIN_CAP) { atomicAdd(&(bar)[XB_TMO], 1u); break; } } } } while (0)

struct XcdBarrier {
    unsigned* bar; unsigned x;
    volatile LAS unsigned* st;
};

__device__ __forceinline__ XcdBarrier xcd_barrier_post(unsigned* bar, volatile LAS unsigned* st) {
    XcdBarrier b; b.bar = bar; b.x = xb_xcc_id(); b.st = st;
    if (threadIdx.x == 0) (void)xb_add(&bar[XB_XCNT(b.x)], 1u);
    return b;
}
__device__ __forceinline__ void xcd_barrier_complete(unsigned* bar, unsigned x, unsigned& nloc, unsigned& nx) {
    const unsigned G = gridDim.x * gridDim.y * gridDim.z;
    unsigned sum, cnt, mine, sp = 0u;
    for (;;) {
        sum = 0u; cnt = 0u; mine = 0u;
#pragma unroll
        for (unsigned j = 0; j < 16; ++j) { const unsigned c = xb_ld(&bar[XB_XCNT(j)]); sum += c; cnt += (c > 0u) ? 1u : 0u; mine = (j == x) ? c : mine; }
        if (sum == G) break;
        __builtin_amdgcn_s_sleep(1);
        if ((++sp & 255u) == 0u) { if (xb_ld(&bar[XB_TMO])) break; if (sp > XB_SPIN_CAP) { atomicAdd(&bar[XB_TMO], 1u); break; } }
    }
    nloc = mine > 0u ? mine : 1u; nx = cnt > 0u ? cnt : 1u;
}

__device__ __forceinline__ void xcd_barrier(const XcdBarrier& b) {
    asm volatile("s_waitcnt vmcnt(0)" ::: "memory");
    __syncthreads();
    if (threadIdx.x == 0) {
        unsigned* bar = b.bar;
        __builtin_amdgcn_s_waitcnt(0);
        unsigned nloc = b.st[0], nx = b.st[1];
        if (nloc == 0u) { xcd_barrier_complete(bar, b.x, nloc, nx); b.st[0] = nloc; b.st[1] = nx; }
        const unsigned old = xb_add(&bar[XB_XSUB(b.x)], 1u);
        const unsigned gen = old / nloc;
        if (old + 1u == (gen + 1u) * nloc) {
            __builtin_amdgcn_fence(__ATOMIC_RELEASE, "agent");
            asm volatile("s_waitcnt vmcnt(0)" ::: "memory");
            const unsigned og = xb_add(&bar[XB_TOP], 1u);
            const unsigned tg = og / nx;
            if (og + 1u == (tg + 1u) * nx) xb_add(&bar[XB_TOPGEN], 1u);
            else XB_SPIN(xb_ld(&bar[XB_TOPGEN]) == tg, bar);
            __builtin_amdgcn_fence(__ATOMIC_ACQUIRE, "agent");
            xb_add(&bar[XB_XGEN(b.x)], 1u);
            asm volatile("s_waitcnt vmcnt(0)" ::: "memory");
        } else {
            XB_SPIN(xb_ld(&bar[XB_XGEN(b.x)]) == gen, bar);
            __builtin_amdgcn_fence(__ATOMIC_ACQUIRE, "agent");
            asm volatile("s_waitcnt vmcnt(0)" ::: "memory");
        }
    }
    __syncthreads();
}

#define GRID_SYNC() do { asm volatile("s_waitcnt vmcnt(0)" ::: "memory"); __syncthreads(); \
    if (threadIdx.x == 0) { asm volatile("buffer_wbl2 sc1\n\ts_waitcnt vmcnt(0)" ::: "memory"); } \
    grid.sync(); asm volatile("buffer_inv sc1\n\ts_waitcnt vmcnt(0)" ::: "memory"); } while (0)
struct EpiFinal {
    static constexpr bool PERM = true, AFTER_DRAIN = false;
    const bf16* XM; float* out; const float* gfin; pg8::rss_t* rss; XcdBarrier xb;
    __device__ __forceinline__ void operator()(pg8::f32x4 (&acc)[2][2][4][2], const pg8::Unit& u, int wr, int wc, int fr, int fq) const {
        asm volatile("" : "+v"(fr), "+v"(fq));
        const int row0 = u.pm * pg8::BM + wr * 64 + fr, col0 = u.pn * pg8::BM + wc * 32 + 8 * fq;
#pragma unroll
        for (int ai = 0; ai < 2; ++ai)
#pragma unroll
            for (int m = 0; m < 4; ++m) { const int r = row0 + ai * pg8::HALF + m * 16; float sq = 0.f;
#pragma unroll
                for (int bj = 0; bj < 2; ++bj) { const size_t off = (size_t)r * D + col0 + bj * pg8::HALF; const v4u w = *(const v4u*)(XM + off);
                    acc[ai][bj][m][0] = acc[ai][bj][m][0] + (f32x4){bf_lo(w.x), bf_hi(w.x), bf_lo(w.y), bf_hi(w.y)};
                    acc[ai][bj][m][1] = acc[ai][bj][m][1] + (f32x4){bf_lo(w.z), bf_hi(w.z), bf_lo(w.w), bf_hi(w.w)};
                    sq += pg8::sumsq4(acc[ai][bj][m][0]) + pg8::sumsq4(acc[ai][bj][m][1]); }
                sq += __shfl_xor(sq, 16); sq += __shfl_xor(sq, 32); if (fq == 0) pg8::rss_add(rss + r, sq);
                if (m == 3) asm volatile("" ::: "memory"); }
        xcd_barrier(xb);
        f32x4 gv[2][2];
#pragma unroll
        for (int bj = 0; bj < 2; ++bj)
#pragma unroll
            for (int n = 0; n < 2; ++n) gv[bj][n] = *(const f32x4*)(gfin + col0 + bj * pg8::HALF + 4 * n);
#pragma unroll
        for (int ai = 0; ai < 2; ++ai)
#pragma unroll
            for (int m = 0; m < 4; ++m) { const int r = row0 + ai * pg8::HALF + m * 16; const float rs = pg8::rstd_of(__hip_atomic_load(rss + r, __ATOMIC_RELAXED, __HIP_MEMORY_SCOPE_AGENT));
#pragma unroll
                for (int bj = 0; bj < 2; ++bj) { const size_t off = (size_t)r * D + col0 + bj * pg8::HALF;
                    *(f32x4*)(out + off) = acc[ai][bj][m][0] * rs * gv[bj][0]; *(f32x4*)(out + off + 4) = acc[ai][bj][m][1] * rs * gv[bj][1]; }
                if (m == 3) asm volatile("" ::: "memory"); }
    }
};
struct Args { const float* in[24]; float* out; unsigned char* ws; int never; int pad; };
enum { I_X = 0, I_NORMG, I_FNG, I_WQKV, I_WO, I_SGIN, I_SGNG, I_SGWS, I_SGB, I_SGO, I_SSMIN, I_LRE, I_LIM, I_LDT, I_BRE, I_BIM, I_CRE, I_CIM, I_SSMD, I_GLU, I_UP, I_CONVW, I_CONVB, I_DOWN };

__global__ void __launch_bounds__(NWAVES * 64, 2) trunk_fwd(Args args) {
    extern __shared__ __attribute__((aligned(16))) unsigned char lds_raw[];
    cg::grid_group grid = cg::this_grid();
    LAS unsigned char* lds = (LAS unsigned char*)lds_raw;
    const int tid = threadIdx.x, lane = tid & 63, wave = __builtin_amdgcn_readfirstlane(tid >> 6);
    const int G = gridDim.x, bid0 = blockIdx.x, gw0 = bid0 * NWAVES + wave, ngw = G * NWAVES;
    unsigned char* ws = args.ws;
    if (tid < 32) ((LAS unsigned*)(lds + MISC_OFF))[tid] = 0u;
    __syncthreads();
    const XcdBarrier xbar = xcd_barrier_post((unsigned*)(ws + WS_BAR), (volatile LAS unsigned*)(lds + MISC_OFF));
    pg8::rss_t* RS = (pg8::rss_t*)(ws + WS_RS);
    bf16* WQKV_T = (bf16*)(ws + WS_WQKV); bf16* WO_T = (bf16*)(ws + WS_WO); bf16* SGIN_T = (bf16*)(ws + WS_SGIN); bf16* SGO_T = (bf16*)(ws + WS_SGO);
    bf16* SSMIN_T = (bf16*)(ws + WS_SSMIN); bf16* GLU_T = (bf16*)(ws + WS_GLU); bf16* UP_T = (bf16*)(ws + WS_UP); bf16* DOWN_T = (bf16*)(ws + WS_DOWN);
    float* EDGE = (float*)(ws + WS_EDGE); unsigned char* BIG = ws + WS_BIG;
    float* X = args.out;
    bf16* XM = (bf16*)(ws + WS_XM);
    const float* x_in = args.in[I_X]; const float* norm_g = args.in[I_NORMG];

    {
        for (int i = bid0 * (NWAVES * 64) + tid; i < 9 * M; i += G * NWAVES * 64) RS[M + i] = 0ull;
        LAS float* scr = (LAS float*)(lds + wave * 16384);
        convert4(args.in[I_WQKV], norm_g, D, 3 * D, WQKV_T, 0, args.in[I_WO], D, D, WO_T, 0, args.in[I_UP], norm_g + D, D, FF2, UP_T, FF, args.in[I_DOWN], FF, D, DOWN_T, 0, scr, gw0, ngw, lane);
        for (int m = gw0; m < M; m += ngw) {
            const f32x4* xr = (const f32x4*)(x_in + (size_t)m * D) + lane; float s = 0.f;
            v2u* o = (v2u*)(XM + (size_t)m * D) + lane;
#pragma unroll
            for (int j = 0; j < 4; ++j) { const f32x4 v = xr[64 * j]; s += pg8::sumsq4(v); v2u w; w.x = pk2(v[0], v[1]); w.y = pk2(v[2], v[3]); o[64 * j] = w; }
            s = wave_sum(s); if (lane == 0) RS[m] = pg8::rss_of(s);
        }
    }
    xcd_barrier(xbar);
    if (args.never) grid.sync();

    const bool fused_final = ((M / 256) * (D / 256) == G);
    for (int step = 0; step < 20; ++step) {
        int bid = (int)blockIdx.x; asm volatile("" : "+s"(bid));
        const int layer = step / 5, sub = step - layer * 5, mixer = layer % 3, j = layer / 3;
        const int gw = bid * NWAVES + wave;
        pg8::rss_t* rs_mid = RS + (size_t)(2 * layer + 1) * M;
        if (sub == 0) {
            const pg8::rss_t* rs_in = RS + (size_t)(2 * layer) * M;
            const bf16* Bt = (mixer == 0) ? WQKV_T + (size_t)j * 3 * D * D : (mixer == 1) ? SGIN_T : SSMIN_T; const int N = (mixer == 0) ? 3 * D : (mixer == 1) ? 2 * D : D;
            pg8::Gemm g{XM, Bt, M, N, D}; pg8::StaticOrder S; S.init(M, N, G, bid);
            pg8::EpiIn E{mixer, (void*)BIG, rs_in, RS + (size_t)9 * M, QSCALE};
            pg8::gemm_phase<pg8::EpiIn, pg8::StaticOrder, true, true>(lds, g, S, E);
        } else if (sub == 1) {
            if (mixer == 0) { bf16* Qb = (bf16*)BIG; bf16* Kb = Qb + (size_t)M * D; bf16* Vb = Kb + (size_t)M * D;
                attn_phase(Qb, Kb, Vb, Vb + (size_t)M * D, lds + wave * 4608, gw, ngw, lane);
            } else if (mixer == 1) { bf16* Hb = (bf16*)BIG; bf16* GATED = Hb + (size_t)M * 2 * D;
                sg_phase(Hb, RS + (size_t)9 * M, args.in[I_SGNG], args.in[I_SGWS], args.in[I_SGB], GATED, lds, G, bid, tid);
            } else { const bf16* Ub = (const bf16*)BIG; bf16* Yb = (bf16*)(BIG + (size_t)M * D * 4);
                if (wave < 2) ssm_phase(Ub, args.in[I_LRE], args.in[I_LIM], args.in[I_LDT], args.in[I_BRE], args.in[I_BIM], args.in[I_CRE], args.in[I_CIM], args.in[I_SSMD], Yb, lds + wave * SSM_WAVE_LDS, bid * 2 + wave, G * 2, lane);
            }
        } else if (sub == 3) {
            const float* cw = args.in[I_CONVW] + (size_t)layer * 3 * FF2; const float* cb = args.in[I_CONVB] + (size_t)layer * FF2;
            pg8::Gemm g{XM, UP_T + (size_t)layer * FF2 * D, M, FF2, D}; pg8::StaticOrder S; S.init(M, FF2, G, bid);
            pg8::EpiUp E{(bf16*)BIG, EDGE, rs_mid, cw, cb, lds + EX_OFF};
            pg8::gemm_phase<pg8::EpiUp, pg8::StaticOrder, true, true>(lds, g, S, E);
            if (layer < 3) {
                const int nun = (M / 256) * (FF2 / 256), maxu = (nun + G - 1) / G; int thr = nun - (maxu - 1) * G; if (thr >= G) thr = 0;
                if (bid >= thr) {
                    const int gwi = (bid - thr) * NWAVES + wave, ngwi = (G - thr) * NWAVES, nl = layer + 1; LAS float* scr = (LAS float*)(lds + wave * 16384);
                    const float* Wa = (nl == 1) ? args.in[I_SGIN] : (nl == 2) ? args.in[I_SSMIN] : args.in[I_WQKV] + (size_t)D * 3 * D;
                    bf16* Ta = (nl == 1) ? SGIN_T : (nl == 2) ? SSMIN_T : WQKV_T + (size_t)3 * D * D; const int Na = (nl == 1) ? 2 * D : (nl == 2) ? D : 3 * D;
                    const float* Wb = (nl == 1) ? args.in[I_SGO] : (nl == 2) ? args.in[I_GLU] : args.in[I_WO] + (size_t)D * D;
                    bf16* Tb = (nl == 1) ? SGO_T : (nl == 2) ? GLU_T : WO_T + (size_t)D * D; const int Nb = (nl == 2) ? 2 * D : D, hb = (nl == 2) ? D : 0;
                    convert4(Wa, norm_g + (size_t)(2 * nl) * D, D, Na, Ta, 0, Wb, D, Nb, Tb, hb, args.in[I_UP] + (size_t)nl * D * FF2, norm_g + (size_t)(2 * nl + 1) * D, D, FF2, UP_T + (size_t)nl * FF2 * D, FF,
                             args.in[I_DOWN] + (size_t)nl * FF * D, FF, D, DOWN_T + (size_t)nl * D * FF, 0, scr, gwi, ngwi, lane);
                }
            }
        } else {
            const bool down = (sub == 4);
            const bf16* A = down ? (const bf16*)BIG : (mixer == 0) ? (const bf16*)BIG + (size_t)3 * M * D : (mixer == 1) ? (const bf16*)BIG + (size_t)M * 2 * D : (const bf16*)(BIG + (size_t)M * D * 4);
            const bf16* Bt = down ? DOWN_T + (size_t)layer * D * FF : (mixer == 0) ? WO_T + (size_t)j * D * D : (mixer == 1) ? SGO_T : GLU_T;
            const bool glu = !down && mixer == 2; const int N = glu ? 2 * D : D, K = down ? FF : D;
            pg8::rss_t* rsn = down ? RS + (size_t)(2 * layer + 2) * M : rs_mid;
            const float* xbase = nullptr;
            pg8::Gemm g{A, Bt, M, N, K}; pg8::StaticOrder S; S.init(M, N, G, bid);
            if (down) ffn_fixup(S, EDGE, args.in[I_CONVW] + (size_t)layer * 3 * FF2, args.in[I_CONVB] + (size_t)layer * FF2, (bf16*)BIG, tid);

            if (down && layer == 3 && fused_final) {
                EpiFinal E{XM, X, args.in[I_FNG], RS + (size_t)8 * M, xbar};
                pg8::gemm_phase<EpiFinal, pg8::StaticOrder, true, true>(lds, g, S, E);
            } else {
                pg8::EpiResid E{xbase, XM, X, rsn, glu, down && layer == 3};
                pg8::gemm_phase<pg8::EpiResid, pg8::StaticOrder, true, true>(lds, g, S, E);
            }
        }
        if (!(fused_final && step == 19)) xcd_barrier(xbar);
    }
    if (!fused_final)
    {
        const f32x4* gr = (const f32x4*)args.in[I_FNG] + lane;
        for (int m = gw0; m < M; m += ngw) {
            f32x4* xr = (f32x4*)(X + (size_t)m * D) + lane; f32x4 v[4]; float s = 0.f;
#pragma unroll
            for (int jj = 0; jj < 4; ++jj) { v[jj] = xr[64 * jj]; s += pg8::sumsq4(v[jj]); }
            const float rs = rsqrtf(wave_sum(s) * (1.0f / 1024.0f) + pg8::RMS_EPS);
#pragma unroll
            for (int jj = 0; jj < 4; ++jj) xr[64 * jj] = v[jj] * rs * gr[64 * jj];
        }
    }
}

extern "C" void kernel_launch(void* const* d_in, const int* in_sizes, int n_in, void* d_out, int out_size, void* d_ws, size_t ws_size, hipStream_t stream) {
    static int grid = 0;
    if (grid == 0) {
        if (n_in != 24 || out_size != M * D || ws_size < WS_END) { fprintf(stderr, "kernel_launch: unexpected problem (n_in %d, out %d, ws %zu)\n", n_in, out_size, ws_size); grid = -1; return; }
        int dev = 0, cus = 0, per_cu = 0;
        hipGetDevice(&dev); hipDeviceGetAttribute(&cus, hipDeviceAttributeMultiprocessorCount, dev);
        if (hipFuncSetAttribute((const void*)trunk_fwd, hipFuncAttributeMaxDynamicSharedMemorySize, LDS_BYTES) != hipSuccess) { fprintf(stderr, "kernel_launch: hipFuncSetAttribute failed\n"); grid = -1; return; }
        if (hipOccupancyMaxActiveBlocksPerMultiprocessor(&per_cu, (const void*)trunk_fwd, NWAVES * 64, LDS_BYTES) != hipSuccess || per_cu < 1) per_cu = 1;
        (void)hipGetLastError();
        grid = cus * 1;
        if (grid <= 0) grid = 256;
    }
    if (grid < 0) return;
    Args a{};
    for (int i = 0; i < 24; ++i) a.in[i] = (const float*)d_in[i];
    a.out = (float*)d_out; a.ws = (unsigned char*)d_ws;
    if (hipMemsetAsync((char*)d_ws + WS_BAR, 0, BAR_BYTES, stream) != hipSuccess) { fprintf(stderr, "kernel_launch: memset of the barrier words failed\n"); return; }
    void* kargs[] = {&a};
    hipError_t e = hipLaunchCooperativeKernel((const void*)trunk_fwd, dim3(grid), dim3(NWAVES * 64), kargs, LDS_BYTES, stream);
    if (e != hipSuccess) fprintf(stderr, "kernel_launch: cooperative launch failed: %s (grid %d)\n", hipGetErrorString(e), grid);
}
```
